# Optimizing an MI355X kernel written in HIP

```python
import jax, jax.numpy as jnp
from jax import lax
import numpy as np

D_MODEL = 1024
BATCH = 4
SEQ = 4096
DEPTH = 1
DEC_BATCH = 16
DEC_SEQ = 2048
PAST_LEN = 128

N_META = 16
D_MIX = D_MODEL
D_CONV = D_MIX // 2
CONV_WIDTH = 3
N_HEADS = 8
QK_NOPE = 64
QK_ROPE = 32
V_HEAD = 64
Q_LORA = (3 * D_MODEL) // 8
KV_LORA = D_MODEL // 4
D_FF = 2816
Q_BLOCK = 128
ROPE_BASE = 10000.0
EPS = 1e-6
D_IN = 3 * D_CONV + Q_LORA + KV_LORA + QK_ROPE

kernel_name = "hybrid_conv_mla_macaron_encoder"


def rms_norm(x, g):
    xf = x.astype(jnp.float32)
    y = xf * lax.rsqrt(jnp.mean(xf * xf, axis=-1, keepdims=True) + EPS)
    return (y * g.astype(jnp.float32)).astype(x.dtype)


def swiglu(x, w_gate, w_up, w_down):
    return (jax.nn.silu(x @ w_gate) * (x @ w_up)) @ w_down


def rope_tables(seq_len):
    pos = jnp.arange(seq_len, dtype=jnp.float32)
    inv_freq = 1.0 / (ROPE_BASE ** (jnp.arange(0, QK_ROPE, 2, dtype=jnp.float32) / QK_ROPE))
    ang = pos[:, None] * inv_freq[None, :]
    return jnp.cos(ang), jnp.sin(ang)


def apply_rope(x, cos, sin):
    xf = x.astype(jnp.float32)
    half = QK_ROPE // 2
    x1, x2 = xf[..., :half], xf[..., half:]
    shape = (1, cos.shape[0]) + (1,) * (x.ndim - 3) + (half,)
    c = cos.reshape(shape)
    s = sin.reshape(shape)
    return jnp.concatenate([x1 * c - x2 * s, x2 * c + x1 * s], axis=-1).astype(x.dtype)


def short_conv_mixer(b_gate, c_gate, h, conv_w):
    u = c_gate * h
    up = jnp.pad(u, ((0, 0), (1, 1), (0, 0)))
    y = up[:, :-2] * conv_w[0] + up[:, 1:-1] * conv_w[1] + up[:, 2:] * conv_w[2]
    return b_gate * y


def latent_attention(q_lat, kv_lat, k_rope_raw, cos, sin, q_norm, w_uq, kv_norm, w_ukv):
    bsz, seq_len, _ = q_lat.shape
    q = (rms_norm(q_lat, q_norm) @ w_uq).reshape(bsz, seq_len, N_HEADS, QK_NOPE + QK_ROPE)
    q_nope = q[..., :QK_NOPE]
    q_rope = apply_rope(q[..., QK_NOPE:], cos, sin)
    kv = (rms_norm(kv_lat, kv_norm) @ w_ukv).reshape(bsz, seq_len, N_HEADS, QK_NOPE + V_HEAD)
    k_nope = kv[..., :QK_NOPE]
    v = kv[..., QK_NOPE:]
    k_rope = apply_rope(k_rope_raw, cos, sin)

    n_blk = -(-seq_len // Q_BLOCK)
    pad = n_blk * Q_BLOCK - seq_len
    scale = (QK_NOPE + QK_ROPE) ** -0.5

    def to_blocks(t):
        t = jnp.pad(t, ((0, 0), (0, pad), (0, 0), (0, 0)))
        return jnp.moveaxis(t.reshape(bsz, n_blk, Q_BLOCK, N_HEADS, t.shape[-1]), 1, 0)

    def attend(blk):
        qn, qr = blk
        s = (jnp.einsum('bqhd,bkhd->bhqk', qn, k_nope, preferred_element_type=jnp.float32)
             + jnp.einsum('bqhd,bkd->bhqk', qr, k_rope, preferred_element_type=jnp.float32))
        p = jax.nn.softmax(s * scale, axis=-1).astype(v.dtype)
        return jnp.einsum('bhqk,bkhd->bqhd', p, v)

    o = lax.map(attend, (to_blocks(q_nope), to_blocks(q_rope)))
    o = jnp.moveaxis(o, 0, 1).reshape(bsz, n_blk * Q_BLOCK, N_HEADS, V_HEAD)[:, :seq_len]
    return o.reshape(bsz, seq_len, N_HEADS * V_HEAD)


def encoder_layer(x, cos, sin, ffn1_norm, ffn1_w_gate, ffn1_w_up, ffn1_w_down,
                  mix_norm, w_in, conv_w, q_norm, w_uq, kv_norm, w_ukv, w_out,
                  ffn2_norm, ffn2_w_gate, ffn2_w_up, ffn2_w_down):
    x = x + 0.5 * swiglu(rms_norm(x, ffn1_norm), ffn1_w_gate, ffn1_w_up, ffn1_w_down)
    z = rms_norm(x, mix_norm) @ w_in
    cuts = [D_CONV, 2 * D_CONV, 3 * D_CONV, 3 * D_CONV + Q_LORA, 3 * D_CONV + Q_LORA + KV_LORA]
    b_gate, c_gate, h, q_lat, kv_lat, k_rope_raw = jnp.split(z, cuts, axis=-1)
    y_conv = short_conv_mixer(b_gate, c_gate, h, conv_w)
    y_att = latent_attention(q_lat, kv_lat, k_rope_raw, cos, sin, q_norm, w_uq, kv_norm, w_ukv)
    x = x + jnp.concatenate([y_conv, y_att], axis=-1) @ w_out
    x = x + 0.5 * swiglu(rms_norm(x, ffn2_norm), ffn2_w_gate, ffn2_w_up, ffn2_w_down)
    return x


def trunk(x, meta_tokens, final_norm, layer_params):
    bsz = x.shape[0]
    meta = jnp.broadcast_to(meta_tokens.astype(x.dtype)[None], (bsz, N_META, D_MODEL))
    h = jnp.concatenate([meta, x], axis=1)
    cos, sin = rope_tables(h.shape[1])
    for l in range(DEPTH):
        h = encoder_layer(h, cos, sin, *[p[l] for p in layer_params])
    h = rms_norm(h, final_norm)
    return h[:, N_META:]


def setup_inputs(seed: int = 0) -> dict:
    key = jax.random.key(seed)
    ks = jax.random.split(key, 24)
    f32 = jnp.float32

    def w(k, shape, fan_in):
        return jax.random.normal(k, shape, f32) * (fan_in ** -0.5)

    def gain(k, shape):
        return 1.0 + 0.02 * jax.random.normal(k, shape, f32)

    return {
        "x_prompt": jax.random.normal(ks[0], (BATCH, SEQ, D_MODEL), f32),
        "x_sample": jax.random.normal(ks[1], (DEC_BATCH, DEC_SEQ, D_MODEL), f32),
        "meta_tokens": jax.random.normal(ks[2], (N_META, D_MODEL), f32),
        "ffn1_norm": gain(ks[3], (DEPTH, D_MODEL)),
        "ffn1_w_gate": w(ks[4], (DEPTH, D_MODEL, D_FF), D_MODEL),
        "ffn1_w_up": w(ks[5], (DEPTH, D_MODEL, D_FF), D_MODEL),
        "ffn1_w_down": w(ks[6], (DEPTH, D_FF, D_MODEL), D_FF),
        "mix_norm": gain(ks[7], (DEPTH, D_MODEL)),
        "w_in": w(ks[8], (DEPTH, D_MODEL, D_IN), D_MODEL),
        "conv_w": w(ks[9], (DEPTH, CONV_WIDTH, D_CONV), CONV_WIDTH),
        "q_norm": gain(ks[10], (DEPTH, Q_LORA)),
        "w_uq": w(ks[11], (DEPTH, Q_LORA, N_HEADS * (QK_NOPE + QK_ROPE)), Q_LORA),
        "kv_norm": gain(ks[12], (DEPTH, KV_LORA)),
        "w_ukv": w(ks[13], (DEPTH, KV_LORA, N_HEADS * (QK_NOPE + V_HEAD)), KV_LORA),
        "w_out": w(ks[14], (DEPTH, D_MIX, D_MODEL), D_MIX),
        "ffn2_norm": gain(ks[15], (DEPTH, D_MODEL)),
        "ffn2_w_gate": w(ks[16], (DEPTH, D_MODEL, D_FF), D_MODEL),
        "ffn2_w_up": w(ks[17], (DEPTH, D_MODEL, D_FF), D_MODEL),
        "ffn2_w_down": w(ks[18], (DEPTH, D_FF, D_MODEL), D_FF),
        "final_norm": gain(ks[19], (D_MODEL,)),
    }


def reference(x_prompt, x_sample, meta_tokens, ffn1_norm, ffn1_w_gate, ffn1_w_up, ffn1_w_down,
              mix_norm, w_in, conv_w, q_norm, w_uq, kv_norm, w_ukv, w_out,
              ffn2_norm, ffn2_w_gate, ffn2_w_up, ffn2_w_down, final_norm):
    layer_params = (ffn1_norm, ffn1_w_gate, ffn1_w_up, ffn1_w_down,
                    mix_norm, w_in, conv_w, q_norm, w_uq, kv_norm, w_ukv, w_out,
                    ffn2_norm, ffn2_w_gate, ffn2_w_up, ffn2_w_down)
    y_prompt = trunk(x_prompt, meta_tokens, final_norm, layer_params)
    y_sample = trunk(x_sample, meta_tokens, final_norm, layer_params)
    return (y_prompt, y_sample)
```

```cpp
#include <hip/hip_runtime.h>
#include <hip/hip_bf16.h>
#include <hip/hip_cooperative_groups.h>
#include <cstdio>
#include <cstdint>
#include <cmath>
namespace cg = cooperative_groups;
namespace pg8 {
#define PG8_LAS __attribute__((address_space(3)))
typedef unsigned short bf16_t;
typedef short bf16x8 __attribute__((ext_vector_type(8)));
typedef float f32x4 __attribute__((ext_vector_type(4)));
typedef unsigned u32x4 __attribute__((ext_vector_type(4)));
constexpr int BM = 256, BK = 64, HALF = 128, HTB = HALF * BK * 2  , STAGE_BYTES = 8 * HTB, NXCD = 8, WGM = 8;

__host__ __device__ __forceinline__ int lds_byte(int r, int c) { const int st = (r >> 4) * 2 + (c >> 5), rr = r & 15, cc = c & 31, ob = rr * 64 + cc * 2; return st * 1024 + (ob ^ (((ob >> 9) & 1) << 5)); }
__host__ __device__ __forceinline__ void stage_rc(int b, int& R, int& C) { const int st = b / 1024, sb = b % 1024, swz = sb ^ (((sb >> 9) & 1) << 5); R = (st >> 1) * 16 + swz / 64; C = (st & 1) * 32 + (swz % 64) / 2; }
__host__ __device__ __forceinline__ int perm32(int rho) { const int n = rho >> 4, i = rho & 15; return 8 * (i >> 2) + 4 * n + (i & 3); }

struct Unit { int pm, pn; };
struct Gemm { const bf16_t* A; const bf16_t* Bt; int M, N, K; };

struct StaticOrder {
    int nM, nN, nwg, G, c;
    __host__ __device__ void init(int M, int N, int G_, int c_) { nM = M / BM; nN = N / BM; nwg = nM * nN; G = G_; c = c_; }
    __host__ __device__ bool next(int i, Unit& u) const {
        const long L = (long)i * G + c; if (L >= nwg) return false;
        int wgid = (int)L; { const int q = nwg / NXCD, r = nwg % NXCD, xcd = wgid % NXCD, off = wgid / NXCD; wgid = (xcd < r ? xcd * (q + 1) : r * (q + 1) + (xcd - r) * q) + off; }
        const int nig = WGM * nN, gid = wgid / nig, fm = gid * WGM, gsz = (nM - fm) < WGM ? (nM - fm) : WGM;
        u.pm = fm + ((wgid % nig) % gsz); u.pn = (wgid % nig) / gsz; return true;
    }
    __device__ __forceinline__ void a_ready(const Unit&) const {}
    __device__ __forceinline__ void done(const Unit&) const {}
};

__device__ __forceinline__ unsigned cvt_pk_bf16(float lo, float hi) { unsigned r; asm volatile("v_cvt_pk_bf16_f32 %0, %1, %2" : "=v"(r) : "v"(lo), "v"(hi)); return r; }
typedef float f32x2 __attribute__((ext_vector_type(2)));
constexpr int NREAL = 49152, MALLR = 49408, NPROMPT = 16384;
constexpr float RMS_EPS = 1e-6f;
__device__ __forceinline__ u32x4 pack8(const f32x4 a, const f32x4 b) { u32x4 w; w.x = cvt_pk_bf16(a[0], a[1]); w.y = cvt_pk_bf16(a[2], a[3]); w.z = cvt_pk_bf16(b[0], b[1]); w.w = cvt_pk_bf16(b[2], b[3]); return w; }
__device__ __forceinline__ float fq_sum(float s) {
    auto a = __builtin_amdgcn_permlane16_swap(__float_as_uint(s), __float_as_uint(s), false, false);
    const float t = __uint_as_float(a[0]) + __uint_as_float(a[1]);
    auto b = __builtin_amdgcn_permlane32_swap(__float_as_uint(t), __float_as_uint(t), false, false);
    return __uint_as_float(b[0]) + __uint_as_float(b[1]);
}
__device__ __forceinline__ float row_rstd(const float* ss, int ngrp, int fq, float invn) {
    float s = 0.f;
    if (fq < ngrp) { const f32x4 v = *(const f32x4*)(ss + 4 * fq); s = (v[0] + v[1]) + (v[2] + v[3]); }
    s += __shfl_xor(s, 16); s += __shfl_xor(s, 32);
    return 1.0f / sqrtf(s * invn + RMS_EPS);
}
__device__ __forceinline__ void rows_rstd(float (&rs)[2][4], const float* ss, int stride, int row0, int ngrp, int fq, float invn) {
    f32x4 sv[2][4];
#pragma unroll
    for (int ai = 0; ai < 2; ++ai)
#pragma unroll
        for (int m = 0; m < 4; ++m) { sv[ai][m] = (f32x4){0.f, 0.f, 0.f, 0.f}; if (fq < ngrp) sv[ai][m] = *(const f32x4*)(ss + (size_t)(row0 + ai * HALF + m * 16) * stride + 4 * fq); }
    __builtin_amdgcn_sched_barrier(0);
#pragma unroll
    for (int ai = 0; ai < 2; ++ai)
#pragma unroll
        for (int m = 0; m < 4; ++m) { const float s = fq_sum((sv[ai][m][0] + sv[ai][m][1]) + (sv[ai][m][2] + sv[ai][m][3])); rs[ai][m] = __builtin_amdgcn_rsqf(s * invn + RMS_EPS); }
}
__device__ __forceinline__ void rows_rstd4(float (&rs)[2][4], const float* ss4, int row0, float invn) {
    f32x4 sv[2][4];
#pragma unroll
    for (int ai = 0; ai < 2; ++ai)
#pragma unroll
        for (int m = 0; m < 4; ++m) sv[ai][m] = *(const f32x4*)(ss4 + (size_t)(row0 + ai * HALF + m * 16) * 4);
    __builtin_amdgcn_sched_barrier(0);
#pragma unroll
    for (int ai = 0; ai < 2; ++ai)
#pragma unroll
        for (int m = 0; m < 4; ++m) rs[ai][m] = __builtin_amdgcn_rsqf(((sv[ai][m][0] + sv[ai][m][1]) + (sv[ai][m][2] + sv[ai][m][3])) * invn + RMS_EPS);
}
constexpr int RED_LDS_OFF = 132096;
__device__ __forceinline__ float sumsq8(const f32x4 a, const f32x4 b) { return ((a[0] * a[0] + a[1] * a[1]) + (a[2] * a[2] + a[3] * a[3])) + ((b[0] * b[0] + b[1] * b[1]) + (b[2] * b[2] + b[3] * b[3])); }
__device__ __forceinline__ int rope_pos(int row) { return row < NPROMPT ? (row & 4095) + 16 : (row < NREAL ? ((row - NPROMPT) & 2047) + 16 : ((row - NREAL) & 255)); }
__device__ __forceinline__ void rope8(f32x4& a, f32x4& b, const float* tab  , int pos, int fq) {
    const float* t = tab + ((size_t)pos * 16 + 8 * (fq & 1)) * 2;
    const f32x4 t0 = *(const f32x4*)(t), t1 = *(const f32x4*)(t + 4), t2 = *(const f32x4*)(t + 8), t3 = *(const f32x4*)(t + 12);
    const float sg = (fq < 2) ? -1.f : 1.f;
    f32x4 pa, pb;
#pragma unroll
    for (int k = 0; k < 4; ++k) { auto ra = __builtin_amdgcn_permlane32_swap(__float_as_uint(a[k]), __float_as_uint(a[k]), false, false); auto rb = __builtin_amdgcn_permlane32_swap(__float_as_uint(b[k]), __float_as_uint(b[k]), false, false);
        pa[k] = __uint_as_float(fq < 2 ? ra[1] : ra[0]); pb[k] = __uint_as_float(fq < 2 ? rb[1] : rb[0]); }
    a[0] = a[0] * t0[0] + sg * pa[0] * t0[1]; a[1] = a[1] * t0[2] + sg * pa[1] * t0[3]; a[2] = a[2] * t1[0] + sg * pa[2] * t1[1]; a[3] = a[3] * t1[2] + sg * pa[3] * t1[3];
    b[0] = b[0] * t2[0] + sg * pb[0] * t2[1]; b[1] = b[1] * t2[2] + sg * pb[1] * t2[3]; b[2] = b[2] * t3[0] + sg * pb[2] * t3[1]; b[3] = b[3] * t3[2] + sg * pb[3] * t3[3];
}
__device__ __forceinline__ float silu_mul(float g, float u) { return g * __builtin_amdgcn_rcpf(1.0f + __builtin_amdgcn_exp2f(-1.4426950408889634f * g)) * u; }

template <bool PRENORM> struct EpiGateUpT {
    static constexpr bool PERM = true, AFTER_DRAIN = false;
    bf16_t* H; const float* SS;
    __device__ __forceinline__ void operator()(const f32x4 (&acc)[2][2][4][2], const Unit& u, int wr, int wc, int fr, int fq) const {
        const int row0 = u.pm * BM + wr * 64 + fr, col0 = u.pn * 128 + wc * 32 + 8 * fq;
        float rsv[2][4];
        if (!PRENORM) rows_rstd4(rsv, SS, row0, 1.0f / 1024.0f);
#pragma unroll
        for (int ai = 0; ai < 2; ++ai)
#pragma unroll
            for (int m = 0; m < 4; ++m) { const int row = row0 + ai * HALF + m * 16; const float rs = PRENORM ? 1.0f : rsv[ai][m];
                f32x4 h0, h1;
#pragma unroll
                for (int k = 0; k < 4; ++k) { h0[k] = silu_mul(acc[ai][0][m][0][k] * rs, acc[ai][1][m][0][k] * rs); h1[k] = silu_mul(acc[ai][0][m][1][k] * rs, acc[ai][1][m][1][k] * rs); }
                __builtin_nontemporal_store(pack8(h0, h1), (u32x4*)(H + (size_t)row * 2816 + col0)); }
    }
};
typedef EpiGateUpT<false> EpiGateUp;
template <int SRC, bool WRITE_XN, bool OUT_BF16 = false> struct EpiResid {
    static constexpr bool PERM = true, AFTER_DRAIN = false;
    const float* xp; const float* xs; const float* meta; float* out; bf16_t* XN; const float* gain; float* SS; float alpha;
    __device__ __forceinline__ void operator()(const f32x4 (&acc)[2][2][4][2], const Unit& u, int wr, int wc, int fr, int fq) const {
        const int row0 = u.pm * BM + wr * 64 + fr, col0 = u.pn * BM + wc * 32 + 8 * fq;
        f32x4 gv[2][2];
        if (WRITE_XN) {
#pragma unroll
            for (int bj = 0; bj < 2; ++bj) { gv[bj][0] = *(const f32x4*)(gain + col0 + bj * HALF); gv[bj][1] = *(const f32x4*)(gain + col0 + bj * HALF + 4); } }
#pragma unroll
        for (int ai = 0; ai < 2; ++ai) {
            f32x4 rv[4][2][2];
#pragma unroll
            for (int m = 0; m < 4; ++m) { const int row = row0 + ai * HALF + m * 16;
                const float* src; bool have = true;
                if (SRC == 1) src = out + (size_t)row * 1024;
                else { if (row < NPROMPT) src = xp + (size_t)row * 1024; else if (row < NREAL) src = xs + (size_t)(row - NPROMPT) * 1024; else if (row < NREAL + 16) src = meta + (size_t)(row - NREAL) * 1024; else { src = meta; have = false; } }
#pragma unroll
                for (int bj = 0; bj < 2; ++bj) { const int c = col0 + bj * HALF;
                    rv[m][bj][0] = (f32x4){0.f, 0.f, 0.f, 0.f}; rv[m][bj][1] = rv[m][bj][0];
                    if (have) { rv[m][bj][0] = *(const f32x4*)(src + c); rv[m][bj][1] = *(const f32x4*)(src + c + 4); } } }
            __builtin_amdgcn_sched_barrier(0);
#pragma unroll
            for (int m = 0; m < 4; ++m) { const int row = row0 + ai * HALF + m * 16;
                float ssq = 0.f;
#pragma unroll
                for (int bj = 0; bj < 2; ++bj) { const int c = col0 + bj * HALF;
                    const f32x4 x0 = rv[m][bj][0] + acc[ai][bj][m][0] * alpha, x1 = rv[m][bj][1] + acc[ai][bj][m][1] * alpha;
                    if (OUT_BF16) __builtin_nontemporal_store(pack8(x0, x1), (u32x4*)(XN + (size_t)row * 1024 + c));
                    else if (row < NREAL) { __builtin_nontemporal_store(x0, (f32x4*)(out + (size_t)row * 1024 + c)); __builtin_nontemporal_store(x1, (f32x4*)(out + (size_t)row * 1024 + c + 4)); }
                    ssq += sumsq8(x0, x1);
                    if (WRITE_XN) __builtin_nontemporal_store(pack8(x0 * gv[bj][0], x1 * gv[bj][1]), (u32x4*)(XN + (size_t)row * 1024 + c)); }
                ssq = fq_sum(ssq);
                if (fq == 0) SS[(size_t)row * 16 + u.pn * 4 + wc] = ssq; }
            __builtin_amdgcn_sched_barrier(0);
        }
    }
};
__device__ __forceinline__ f32x4 bf_lo4(const u32x4 w) { return (f32x4){__uint_as_float(w.x << 16), __uint_as_float(w.x & 0xffff0000u), __uint_as_float(w.y << 16), __uint_as_float(w.y & 0xffff0000u)}; }
__device__ __forceinline__ f32x4 bf_hi4(const u32x4 w) { return (f32x4){__uint_as_float(w.z << 16), __uint_as_float(w.z & 0xffff0000u), __uint_as_float(w.w << 16), __uint_as_float(w.w & 0xffff0000u)}; }
template <int SRC> struct EpiResidB {
    static constexpr bool PERM = true, AFTER_DRAIN = false;
    const float* xp; const float* xs; const bf16_t* RB; bf16_t* OB; float* SS; float alpha;
    __device__ __forceinline__ void operator()(const f32x4 (&acc)[2][2][4][2], const Unit& u, int wr, int wc, int fr, int fq) const {
        const int row0 = u.pm * BM + wr * 64 + fr, col0 = u.pn * BM + wc * 32 + 8 * fq;
        PG8_LAS float* red = (PG8_LAS float*)(unsigned)RED_LDS_OFF;
#pragma unroll
        for (int ai = 0; ai < 2; ++ai) {
            f32x4 rv[4][2][2]; u32x4 rb[4][2];
#pragma unroll
            for (int m = 0; m < 4; ++m) { const int row = row0 + ai * HALF + m * 16;
                if (SRC == 0) { const float* src = row < NPROMPT ? xp + (size_t)row * 1024 : xs + (size_t)(row - NPROMPT) * 1024;
#pragma unroll
                    for (int bj = 0; bj < 2; ++bj) { rv[m][bj][0] = __builtin_nontemporal_load((const f32x4*)(src + col0 + bj * HALF)); rv[m][bj][1] = __builtin_nontemporal_load((const f32x4*)(src + col0 + bj * HALF + 4)); } }
                else {
#pragma unroll
                    for (int bj = 0; bj < 2; ++bj) rb[m][bj] = __builtin_nontemporal_load((const u32x4*)(RB + (size_t)row * 1024 + col0 + bj * HALF)); } }
            __builtin_amdgcn_sched_barrier(0);
#pragma unroll
            for (int m = 0; m < 4; ++m) { const int row = row0 + ai * HALF + m * 16; float ssq = 0.f;
#pragma unroll
                for (int bj = 0; bj < 2; ++bj) { const int c = col0 + bj * HALF;
                    const f32x4 r0 = SRC == 0 ? rv[m][bj][0] : bf_lo4(rb[m][bj]), r1 = SRC == 0 ? rv[m][bj][1] : bf_hi4(rb[m][bj]);
                    const f32x4 x0 = r0 + acc[ai][bj][m][0] * alpha, x1 = r1 + acc[ai][bj][m][1] * alpha;
                    ssq += sumsq8(x0, x1);
                    __builtin_nontemporal_store(pack8(x0, x1), (u32x4*)(OB + (size_t)row * 1024 + c)); }
                ssq = fq_sum(ssq);
                if (fq == 0) red[(ai * HALF + wr * 64 + m * 16 + fr) * 4 + wc] = ssq; }
            __builtin_amdgcn_sched_barrier(0);
        }
        asm volatile("s_waitcnt lgkmcnt(0)" ::: "memory"); __builtin_amdgcn_s_barrier(); asm volatile("" ::: "memory");
        if (threadIdx.x < 256) { const f32x4 pv = *(const PG8_LAS f32x4*)(red + threadIdx.x * 4);
            SS[(size_t)(u.pm * BM + threadIdx.x) * 4 + u.pn] = (pv[0] + pv[1]) + (pv[2] + pv[3]); }
    }
};
struct EpiWin {
    static constexpr bool PERM = true, AFTER_DRAIN = false;
    const float* SSa; bf16_t* MIX; bf16_t* U; bf16_t* QL; bf16_t* KVL; bf16_t* KR; float* SSb; const float* qnorm; const float* kvnorm; const float* rope;
    __device__ __forceinline__ void operator()(const f32x4 (&acc)[2][2][4][2], const Unit& u, int wr, int wc, int fr, int fq) const {
        const int row0 = u.pm * BM + wr * 64 + fr, cw = wc * 32 + 8 * fq, pn = u.pn;
        float rsv[2][4];
        if (u.pm == NREAL / BM) rows_rstd(rsv, SSa + (size_t)MALLR * 4, 16, row0 - NREAL, 4, fq, 1.0f / 1024.0f);
        else rows_rstd4(rsv, SSa, row0, 1.0f / 1024.0f);
#pragma unroll
        for (int ai = 0; ai < 2; ++ai)
#pragma unroll
            for (int m = 0; m < 4; ++m) { const int row = row0 + ai * HALF + m * 16; const float rs = rsv[ai][m];
                f32x4 z[2][2];
#pragma unroll
                for (int bj = 0; bj < 2; ++bj) { z[bj][0] = acc[ai][bj][m][0] * rs; z[bj][1] = acc[ai][bj][m][1] * rs; }
                if (pn < 2) {
                    if (row < NREAL) {
#pragma unroll
                        for (int bj = 0; bj < 2; ++bj) __builtin_nontemporal_store(pack8(z[bj][0], z[bj][1]), (u32x4*)(MIX + (size_t)row * 1024 + pn * BM + bj * HALF + cw)); }
                } else if (pn < 6) {
                    __builtin_nontemporal_store(pack8(z[0][0] * z[1][0], z[0][1] * z[1][1]), (u32x4*)(U + (size_t)row * 512 + (pn - 2) * 128 + cw));
                } else {
#pragma unroll
                    for (int bj = 0; bj < 2; ++bj) { const int half = 2 * pn + bj;
                        if (half <= 14) { const int c = (half - 12) * 128 + cw; const float s = fq_sum(sumsq8(z[bj][0], z[bj][1]));
                            if (fq == 0) SSb[(size_t)row * 32 + (half - 12) * 4 + wc] = s;
                            const f32x4 g0 = *(const f32x4*)(qnorm + c), g1 = *(const f32x4*)(qnorm + c + 4);
                            __builtin_nontemporal_store(pack8(z[bj][0] * g0, z[bj][1] * g1), (u32x4*)(QL + (size_t)row * 384 + c));
                        } else if (half <= 16) { const int c = (half - 15) * 128 + cw; const float s = fq_sum(sumsq8(z[bj][0], z[bj][1]));
                            if (fq == 0) SSb[(size_t)row * 32 + 12 + (half - 15) * 4 + wc] = s;
                            const f32x4 g0 = *(const f32x4*)(kvnorm + c), g1 = *(const f32x4*)(kvnorm + c + 4);
                            __builtin_nontemporal_store(pack8(z[bj][0] * g0, z[bj][1] * g1), (u32x4*)(KVL + (size_t)row * 256 + c));
                        } else if (wc == 0) { f32x4 a = z[bj][0], b = z[bj][1]; rope8(a, b, rope, rope_pos(row), fq);
                            __builtin_nontemporal_store(pack8(a, b), (u32x4*)(KR + (size_t)row * 32 + 8 * fq)); } }
                } }
    }
};
struct EpiQup {
    static constexpr bool PERM = true, AFTER_DRAIN = false;
    const float* SSb; bf16_t* Q; const float* rope;
    __device__ __forceinline__ void operator()(const f32x4 (&acc)[2][2][4][2], const Unit& u, int wr, int wc, int fr, int fq) const {
        const int row0 = u.pm * BM + wr * 64 + fr;
        float rsv[2][4]; rows_rstd(rsv, SSb, 32, row0, 3, fq, 1.0f / 384.0f);
#pragma unroll
        for (int ai = 0; ai < 2; ++ai)
#pragma unroll
            for (int m = 0; m < 4; ++m) { const int row = row0 + ai * HALF + m * 16; const float rs = rsv[ai][m];
#pragma unroll
                for (int bj = 0; bj < 2; ++bj) { const int c32 = u.pn * 8 + bj * 4 + wc; f32x4 a = acc[ai][bj][m][0] * rs, b = acc[ai][bj][m][1] * rs;
                    if (c32 % 3 == 2) rope8(a, b, rope, rope_pos(row), fq);
                    __builtin_nontemporal_store(pack8(a, b), (u32x4*)(Q + (size_t)row * 768 + c32 * 32 + 8 * fq)); } }
    }
};
struct EpiKVup {
    static constexpr bool PERM = true, AFTER_DRAIN = false;
    const float* SSb; bf16_t* KV;
    __device__ __forceinline__ void operator()(const f32x4 (&acc)[2][2][4][2], const Unit& u, int wr, int wc, int fr, int fq) const {
        const int row0 = u.pm * BM + wr * 64 + fr, col0 = u.pn * BM + wc * 32 + 8 * fq;
        float rsv[2][4]; rows_rstd(rsv, SSb + 12, 32, row0, 2, fq, 1.0f / 256.0f);
#pragma unroll
        for (int ai = 0; ai < 2; ++ai)
#pragma unroll
            for (int m = 0; m < 4; ++m) { const int row = row0 + ai * HALF + m * 16; const float rs = rsv[ai][m];
#pragma unroll
                for (int bj = 0; bj < 2; ++bj) __builtin_nontemporal_store(pack8(acc[ai][bj][m][0] * rs, acc[ai][bj][m][1] * rs), (u32x4*)(KV + (size_t)row * 1024 + col0 + bj * HALF)); }
    }
};
template <class Epi, class Sched, bool ALIGN_EPI = false, bool SP2 = false>
__device__ __forceinline__ void gemm_phase(PG8_LAS unsigned char* lds, const Gemm g, const Sched& S, const Epi& E) {
    const int tid = threadIdx.x, wid = __builtin_amdgcn_readfirstlane(tid >> 6), lane = tid & 63, wr = wid >> 2, wc = wid & 3, fr = lane & 15, fq = lane >> 4;
    const int K = g.K, nt = K / BK;
    unsigned voffA[2], voffB[2];
#pragma unroll
    for (int i = 0; i < 2; ++i) { int R, C; stage_rc(tid * 16 + i * 8192, R, C); const int Rb = Epi::PERM ? ((R & ~31) + perm32(R & 31)) : R;
        voffA[i] = (unsigned)(R * K + C) * 2u; voffB[i] = (unsigned)(Rb * K + C) * 2u; }
    const size_t kstep = (size_t)(BK * 2);
    const size_t hstep = (size_t)HALF * K * 2;
    const size_t tstep = 2 * hstep;
    const unsigned ldsw = (unsigned)wid * 1024u;
    const int aoff = lds_byte(wr * 64 + fr, fq * 8), boff = lds_byte(wc * 32 + fr, fq * 8);
#define PG8_SA(b, h) (((b) * 2 + (h)) * HTB)
#define PG8_SB(b, h) ((4 + (b) * 2 + (h)) * HTB)
#define PG8_STAGE(bufoff, gbase, voff) do { _Pragma("unroll") for (int _i = 0; _i < 2; ++_i) \
        __builtin_amdgcn_global_load_lds((const unsigned*)((const char*)(gbase) + (voff)[_i]), (PG8_LAS unsigned*)(lds + (bufoff) + ldsw + _i * 8192), 16, 0, 0); } while (0)
#define PG8_LDA(dst, b, h) do { _Pragma("unroll") for (int m = 0; m < 4; ++m) _Pragma("unroll") for (int k = 0; k < 2; ++k) dst[m][k] = *(const PG8_LAS bf16x8*)(lds + PG8_SA(b, h) + aoff + m * 2048 + k * 1024); } while (0)
#define PG8_LDB(dst, b, h) do { _Pragma("unroll") for (int n = 0; n < 2; ++n) _Pragma("unroll") for (int k = 0; k < 2; ++k) dst[n][k] = *(const PG8_LAS bf16x8*)(lds + PG8_SB(b, h) + boff + n * 2048 + k * 1024); } while (0)
#define PG8_MMA(ai, bj, At, Bt) do { __builtin_amdgcn_s_setprio(1); _Pragma("unroll") for (int m = 0; m < 4; ++m) _Pragma("unroll") for (int n = 0; n < 2; ++n) _Pragma("unroll") for (int k = 0; k < 2; ++k) \
        acc[ai][bj][m][n] = __builtin_amdgcn_mfma_f32_16x16x32_bf16(Bt[n][k], At[m][k], acc[ai][bj][m][n], 0, 0, 0); __builtin_amdgcn_s_setprio(0); } while (0)
#define PG8_WAIT_V(n) asm volatile("s_waitcnt vmcnt(" #n ")" ::: "memory")
#define PG8_WAIT_L(n) asm volatile("s_waitcnt lgkmcnt(" #n ")" ::: "memory")
#define PG8_BAR __builtin_amdgcn_s_barrier()
#define PG8_SCHED __builtin_amdgcn_sched_barrier(0)
    Unit cur, nxt; int ui = 0;
    if (!S.next(0, cur)) return;
    f32x4 acc[2][2][4][2];
#pragma unroll
    for (int a = 0; a < 2; ++a)
#pragma unroll
        for (int b = 0; b < 2; ++b)
#pragma unroll
            for (int m = 0; m < 4; ++m)
#pragma unroll
                for (int n = 0; n < 2; ++n) acc[a][b][m][n] = (f32x4){0.f, 0.f, 0.f, 0.f};
    bf16x8 At[4][2], B0[2][2], B1[2][2];
    const char* cA = (const char*)g.A + (size_t)cur.pm * tstep; const char* cB = (const char*)g.Bt + (size_t)cur.pn * tstep;
    S.a_ready(cur);
    if constexpr (SP2) {
        PG8_STAGE(PG8_SB(0, 0), cB, voffB); PG8_STAGE(PG8_SB(0, 1), cB + hstep, voffB); PG8_STAGE(PG8_SA(0, 0), cA, voffA); PG8_STAGE(PG8_SA(0, 1), cA + hstep, voffA);
        if (wr == 1) PG8_BAR;
        PG8_WAIT_V(2); PG8_BAR;
        PG8_STAGE(PG8_SB(1, 0), cB + kstep, voffB); PG8_STAGE(PG8_SA(1, 0), cA + kstep, voffA); PG8_STAGE(PG8_SB(1, 1), cB + hstep + kstep, voffB);
        PG8_WAIT_V(6); PG8_BAR;
    } else {
        PG8_STAGE(PG8_SB(0, 0), cB, voffB); PG8_STAGE(PG8_SA(0, 0), cA, voffA); PG8_STAGE(PG8_SB(0, 1), cB + hstep, voffB); PG8_STAGE(PG8_SA(0, 1), cA + hstep, voffA);
        if (wr == 1) PG8_BAR;
        PG8_WAIT_V(4); PG8_BAR;
        PG8_STAGE(PG8_SB(1, 0), cB + kstep, voffB); PG8_STAGE(PG8_SA(1, 0), cA + kstep, voffA); PG8_STAGE(PG8_SB(1, 1), cB + hstep + kstep, voffB);
        PG8_WAIT_V(6); PG8_BAR;
    }
    for (;;) {
        const bool has_next = S.next(ui + 1, nxt);
        const char* nA = has_next ? (const char*)g.A + (size_t)nxt.pm * tstep : cA; const char* nB = has_next ? (const char*)g.Bt + (size_t)nxt.pn * tstep : cB;
        for (int t = 0; t < nt; t += 2) {
            const bool last = (t == nt - 2);
            const char* a1 = cA + (size_t)(t + 1) * kstep;
            const char* a2 = last ? nA : cA + (size_t)(t + 2) * kstep; const char* b2 = last ? nB : cB + (size_t)(t + 2) * kstep;
            const char* a3 = a2 + kstep; const char* b3 = b2 + kstep;
            if (last && has_next) S.a_ready(nxt);
            if constexpr (SP2) {
            PG8_LDB(B0, 0, 0); PG8_LDB(B1, 0, 1); PG8_SCHED; PG8_LDA(At, 0, 0); PG8_STAGE(PG8_SA(1, 1), a1 + hstep, voffA);
            PG8_WAIT_V(8); PG8_WAIT_L(0); PG8_BAR; PG8_MMA(0, 0, At, B0); PG8_MMA(0, 1, At, B1); PG8_BAR; PG8_SCHED;
            PG8_LDA(At, 0, 1); PG8_STAGE(PG8_SB(0, 0), b2, voffB); PG8_STAGE(PG8_SB(0, 1), b2 + hstep, voffB); PG8_STAGE(PG8_SA(0, 0), a2, voffA);
            PG8_WAIT_V(8); PG8_WAIT_L(0); PG8_BAR; PG8_MMA(1, 0, At, B0); PG8_MMA(1, 1, At, B1); PG8_BAR; PG8_SCHED;
            PG8_LDB(B0, 1, 0); PG8_LDB(B1, 1, 1); PG8_SCHED; PG8_LDA(At, 1, 0); PG8_STAGE(PG8_SA(0, 1), a2 + hstep, voffA);
            PG8_WAIT_V(8); PG8_WAIT_L(0); PG8_BAR; PG8_MMA(0, 0, At, B0); PG8_MMA(0, 1, At, B1); PG8_BAR; PG8_SCHED;
            PG8_LDA(At, 1, 1); PG8_STAGE(PG8_SB(1, 0), b3, voffB); PG8_STAGE(PG8_SB(1, 1), b3 + hstep, voffB); PG8_STAGE(PG8_SA(1, 0), a3, voffA);
            PG8_WAIT_V(8); PG8_WAIT_L(0); PG8_BAR; PG8_MMA(1, 0, At, B0); PG8_MMA(1, 1, At, B1); PG8_BAR; PG8_SCHED;
            } else {
            PG8_LDB(B0, 0, 0); PG8_SCHED; PG8_LDA(At, 0, 0); PG8_STAGE(PG8_SA(1, 1), a1 + hstep, voffA);
            PG8_WAIT_L(8); PG8_BAR; PG8_WAIT_L(0); PG8_MMA(0, 0, At, B0); PG8_BAR; PG8_SCHED;
            PG8_LDB(B1, 0, 1); PG8_STAGE(PG8_SB(0, 0), b2, voffB);
            PG8_BAR; PG8_WAIT_L(0); PG8_MMA(0, 1, At, B1); PG8_BAR;
            PG8_LDA(At, 0, 1); PG8_STAGE(PG8_SA(0, 0), a2, voffA);
            PG8_BAR; PG8_WAIT_L(0); PG8_MMA(1, 0, At, B0); PG8_BAR; PG8_SCHED;
            PG8_STAGE(PG8_SB(0, 1), b2 + hstep, voffB);
            PG8_WAIT_V(6); PG8_BAR; PG8_MMA(1, 1, At, B1); PG8_BAR;
            PG8_LDB(B0, 1, 0); PG8_SCHED; PG8_LDA(At, 1, 0); PG8_STAGE(PG8_SA(0, 1), a2 + hstep, voffA);
            PG8_WAIT_L(8); PG8_BAR; PG8_WAIT_L(0); PG8_MMA(0, 0, At, B0); PG8_BAR; PG8_SCHED;
            PG8_LDB(B1, 1, 1); PG8_STAGE(PG8_SB(1, 0), b3, voffB);
            PG8_BAR; PG8_WAIT_L(0); PG8_MMA(0, 1, At, B1); PG8_BAR;
            PG8_LDA(At, 1, 1); PG8_STAGE(PG8_SA(1, 0), a3, voffA);
            PG8_BAR; PG8_WAIT_L(0); PG8_MMA(1, 0, At, B0); PG8_BAR; PG8_SCHED;
            PG8_STAGE(PG8_SB(1, 1), b3 + hstep, voffB);
            PG8_WAIT_V(6); PG8_BAR; PG8_MMA(1, 1, At, B1); PG8_BAR;
            }
        }
        if constexpr (ALIGN_EPI) { if (wr == 0) PG8_BAR; }
        if constexpr (!Epi::AFTER_DRAIN) { E(acc, cur, wr, wc, fr, fq); S.done(cur); }
        if (!has_next) break;
#pragma unroll
        for (int a = 0; a < 2; ++a)
#pragma unroll
            for (int b = 0; b < 2; ++b)
#pragma unroll
                for (int m = 0; m < 4; ++m)
#pragma unroll
                    for (int n = 0; n < 2; ++n) acc[a][b][m][n] = (f32x4){0.f, 0.f, 0.f, 0.f};
        cur = nxt; cA = nA; cB = nB; ++ui;
        if constexpr (ALIGN_EPI) { if (wr == 1) PG8_BAR; }
    }
    PG8_WAIT_V(0);
    if constexpr (!ALIGN_EPI) { if (wr == 0) PG8_BAR; }
    PG8_BAR;
    if constexpr (Epi::AFTER_DRAIN) { E.fused(acc, cur, wr, wc, fr, fq, lds, wid, lane); S.done(cur); }
#undef PG8_SA
#undef PG8_SB
#undef PG8_STAGE
#undef PG8_LDA
#undef PG8_LDB
#undef PG8_MMA
#undef PG8_WAIT_V
#undef PG8_WAIT_L
#undef PG8_BAR
#undef PG8_SCHED
}
}
namespace att {
using bf16x8 = __attribute__((ext_vector_type(8))) short;
using s16x4  = __attribute__((ext_vector_type(4))) short;
using f32x16 = __attribute__((ext_vector_type(16))) float;
using u32x4  = __attribute__((ext_vector_type(4))) unsigned;
typedef unsigned short bf16_t;
constexpr int NW = 8, QBLK = 32, KVBLK = 64;
constexpr float SCALE = 0.10206207261596577f;
constexpr float THR = 8.f;
constexpr int SHM_V = 16384, SHM_K = 16384, SHM_ATTN = 3 * (SHM_V + SHM_K) + NW * 64 * 4;
constexpr int LDQ = 768, LDKV = 1024, LDKR = 32, LDO = 1024, META_ROW0 = 49152;
#define KSWZ(row, colB) ((row) * 256 + ((colB) ^ (((row) & 15) << 4)))
#define SBAR() __builtin_amdgcn_sched_barrier(0)
__device__ __forceinline__ int crow(int r, int hi) { return (r & 3) + 8 * (r >> 2) + 4 * hi; }
__device__ __forceinline__ unsigned cvtpk(float lo, float hi) { unsigned r; asm volatile("v_cvt_pk_bf16_f32 %0, %1, %2" : "=v"(r) : "v"(lo), "v"(hi)); return r; }
__device__ __forceinline__ bf16x8 ld8(const bf16_t* p) { return *reinterpret_cast<const bf16x8*>(p); }

__device__ __forceinline__ void partialSM(f32x16& p0, f32x16& p1, float& m_reg, float& mn, float& alpha) {
  constexpr float C = SCALE * 1.4426950408889634f;
  float pmax = p0[0];
#pragma unroll
  for (int r = 1; r < 16; ++r) pmax = fmaxf(pmax, p0[r]);
#pragma unroll
  for (int r = 0; r < 16; ++r) pmax = fmaxf(pmax, p1[r]);
  { auto rr = __builtin_amdgcn_permlane32_swap(__float_as_uint(pmax), __float_as_uint(pmax), false, false);
    pmax = fmaxf(__uint_as_float(rr[0]), __uint_as_float(rr[1])); }
  if (__builtin_expect(__all(pmax - m_reg <= THR / SCALE), 1)) { mn = m_reg; alpha = 1.f; }
  else { mn = fmaxf(m_reg, pmax); alpha = __builtin_amdgcn_exp2f((m_reg - mn) * C); m_reg = mn; }
  float mnC = -mn * C;
#pragma unroll
  for (int r = 0; r < 16; ++r) p0[r] = fmaf(p0[r], C, mnC);
#pragma unroll
  for (int r = 0; r < 16; ++r) p1[r] = fmaf(p1[r], C, mnC);
#pragma unroll
  for (int r = 0; r < 16; ++r) p0[r] = __builtin_amdgcn_exp2f(p0[r]);
}
__device__ __forceinline__ void finishSM(f32x16& p0, f32x16& p1, float alpha, float& l_reg, bf16x8& pa0, bf16x8& pa1, bf16x8& pa2, bf16x8& pa3) {
#pragma unroll
  for (int r = 0; r < 16; ++r) p1[r] = __builtin_amdgcn_exp2f(p1[r]);
  float ps = 0;
#pragma unroll
  for (int r = 0; r < 16; ++r) ps += p0[r];
#pragma unroll
  for (int r = 0; r < 16; ++r) ps += p1[r];
  { auto rr = __builtin_amdgcn_permlane32_swap(__float_as_uint(ps), __float_as_uint(ps), false, false);
    ps = __uint_as_float(rr[0]) + __uint_as_float(rr[1]); }
  l_reg = l_reg * alpha + ps;
#define PK4(P, BASE, OUT) do { unsigned a0 = cvtpk(P[BASE + 0], P[BASE + 1]), a1 = cvtpk(P[BASE + 2], P[BASE + 3]);   \
    unsigned b0 = cvtpk(P[BASE + 4], P[BASE + 5]), b1 = cvtpk(P[BASE + 6], P[BASE + 7]);                              \
    auto r0 = __builtin_amdgcn_permlane32_swap(a0, b0, false, false); auto r1 = __builtin_amdgcn_permlane32_swap(a1, b1, false, false); \
    u32x4 w = {r0[0], r1[0], r0[1], r1[1]}; OUT = *reinterpret_cast<bf16x8*>(&w); } while (0)
  PK4(p0, 0, pa0); PK4(p0, 8, pa1); PK4(p1, 0, pa2); PK4(p1, 8, pa3);
#undef PK4
}
__device__ __forceinline__ void qkt(f32x16& p0, f32x16& p1, const char* Ks, const bf16x8* qr, int r32, int hi) {
  p0 = f32x16{}; p1 = f32x16{};
#pragma unroll
  for (int d0 = 0; d0 < 6; ++d0) { const int cb = (d0 * 16 + hi * 8) * 2;
    bf16x8 b0 = *reinterpret_cast<const bf16x8*>(Ks + KSWZ(r32, cb));
    bf16x8 b1 = *reinterpret_cast<const bf16x8*>(Ks + KSWZ(32 + r32, cb));
    p0 = __builtin_amdgcn_mfma_f32_32x32x16_bf16(b0, qr[d0], p0, 0, 0, 0);
    p1 = __builtin_amdgcn_mfma_f32_32x32x16_bf16(b1, qr[d0], p1, 0, 0, 0); }
}
__device__ __forceinline__ int v_st(int k, int c) { const int kk = (k & ~0xC) | ((k & 4) << 1) | ((k & 8) >> 1); return ((kk >> 3) * 4 + (c >> 5)) * 512 + ((kk & 7) * 32 + (c & 31)) * 2; }
__device__ __forceinline__ int v_rd_base(int lane) { return ((lane & 3) << 3) | (((lane >> 2) & 3) << 6) | (((lane >> 4) & 1) << 5) | (((lane >> 5) & 1) << 8); }
constexpr int v_rd_off(int d0, int ks, int half) { return d0 * 512 + ks * 4096 + half * 2048; }
template <int OFF> __device__ __forceinline__ s16x4 tr_read(int vb) {
  s16x4 r; asm volatile("ds_read_b64_tr_b16 %0, %1 offset:%2" : "=&v"(r) : "v"(vb), "i"(OFF) : "memory"); return r;
}
template <int D0> __device__ __forceinline__ void pv_one(f32x16& od, int vb, bf16x8 pa0, bf16x8 pa1, bf16x8 pa2, bf16x8 pa3) {
  const s16x4 l0 = tr_read<v_rd_off(D0, 0, 0)>(vb), h0 = tr_read<v_rd_off(D0, 0, 1)>(vb), l1 = tr_read<v_rd_off(D0, 1, 0)>(vb), h1 = tr_read<v_rd_off(D0, 1, 1)>(vb);
  const s16x4 l2 = tr_read<v_rd_off(D0, 2, 0)>(vb), h2 = tr_read<v_rd_off(D0, 2, 1)>(vb), l3 = tr_read<v_rd_off(D0, 3, 0)>(vb), h3 = tr_read<v_rd_off(D0, 3, 1)>(vb);
  asm volatile("s_waitcnt lgkmcnt(0)" ::: "memory"); SBAR();
#define PK(L, H) (bf16x8){L[0], L[1], L[2], L[3], H[0], H[1], H[2], H[3]}
  od = __builtin_amdgcn_mfma_f32_32x32x16_bf16(pa0, PK(l0, h0), od, 0, 0, 0);
  od = __builtin_amdgcn_mfma_f32_32x32x16_bf16(pa1, PK(l1, h1), od, 0, 0, 0);
  od = __builtin_amdgcn_mfma_f32_32x32x16_bf16(pa2, PK(l2, h2), od, 0, 0, 0);
  od = __builtin_amdgcn_mfma_f32_32x32x16_bf16(pa3, PK(l3, h3), od, 0, 0, 0);
#undef PK
}
__device__ __forceinline__ void pv_d0(f32x16* o, int vb, bf16x8 pa0, bf16x8 pa1, bf16x8 pa2, bf16x8 pa3) {
  const s16x4 l0 = tr_read<v_rd_off(0, 0, 0)>(vb), h0 = tr_read<v_rd_off(0, 0, 1)>(vb), l1 = tr_read<v_rd_off(0, 1, 0)>(vb), h1 = tr_read<v_rd_off(0, 1, 1)>(vb);
  const s16x4 l2 = tr_read<v_rd_off(0, 2, 0)>(vb), h2 = tr_read<v_rd_off(0, 2, 1)>(vb), l3 = tr_read<v_rd_off(0, 3, 0)>(vb), h3 = tr_read<v_rd_off(0, 3, 1)>(vb);
  const s16x4 m0 = tr_read<v_rd_off(1, 0, 0)>(vb), g0 = tr_read<v_rd_off(1, 0, 1)>(vb), m1 = tr_read<v_rd_off(1, 1, 0)>(vb), g1 = tr_read<v_rd_off(1, 1, 1)>(vb);
  const s16x4 m2 = tr_read<v_rd_off(1, 2, 0)>(vb), g2 = tr_read<v_rd_off(1, 2, 1)>(vb), m3 = tr_read<v_rd_off(1, 3, 0)>(vb), g3 = tr_read<v_rd_off(1, 3, 1)>(vb);
  asm volatile("s_waitcnt lgkmcnt(8)" ::: "memory"); SBAR();
#define PK(L, H) (bf16x8){L[0], L[1], L[2], L[3], H[0], H[1], H[2], H[3]}
  o[0] = __builtin_amdgcn_mfma_f32_32x32x16_bf16(pa0, PK(l0, h0), o[0], 0, 0, 0);
  o[0] = __builtin_amdgcn_mfma_f32_32x32x16_bf16(pa1, PK(l1, h1), o[0], 0, 0, 0);
  o[0] = __builtin_amdgcn_mfma_f32_32x32x16_bf16(pa2, PK(l2, h2), o[0], 0, 0, 0);
  o[0] = __builtin_amdgcn_mfma_f32_32x32x16_bf16(pa3, PK(l3, h3), o[0], 0, 0, 0);
  SBAR(); asm volatile("s_waitcnt lgkmcnt(0)" ::: "memory"); SBAR();
  o[1] = __builtin_amdgcn_mfma_f32_32x32x16_bf16(pa0, PK(m0, g0), o[1], 0, 0, 0);
  o[1] = __builtin_amdgcn_mfma_f32_32x32x16_bf16(pa1, PK(m1, g1), o[1], 0, 0, 0);
  o[1] = __builtin_amdgcn_mfma_f32_32x32x16_bf16(pa2, PK(m2, g2), o[1], 0, 0, 0);
  o[1] = __builtin_amdgcn_mfma_f32_32x32x16_bf16(pa3, PK(m3, g3), o[1], 0, 0, 0);
#undef PK
}

__device__ __forceinline__ void attn_unit(const bf16_t* __restrict__ Q, const bf16_t* __restrict__ KV, const bf16_t* __restrict__ KR, bf16_t* __restrict__ O,
                                          int qrow0, int kvrow0, int NT, int h, char* lds) {
  const int tid = threadIdx.x, wid = __builtin_amdgcn_readfirstlane(tid >> 6), lane = tid & 63, r32 = lane & 31, hi = lane >> 5;
  const bool grpA = wid < 4;
  constexpr int SLOT = SHM_K + SHM_V;
  char* ring = lds;
  float* ws = (float*)(lds + 3 * SLOT) + wid * 64; float* li_l = ws; float* al_l = ws + 32;
  float m_reg = -1e30f, l_reg = 0; f32x16 o[2] = {}; bf16x8 qr[6];
  const bf16_t* Qw = Q + (size_t)(qrow0 + wid * QBLK + r32) * LDQ + h * 96 + hi * 8;
#pragma unroll
  for (int d0 = 0; d0 < 6; ++d0) qr[d0] = ld8(Qw + d0 * 16);
  const int sr = tid >> 3, sc = tid & 7;
  const int vst = SHM_K + v_st(sr, sc * 8), kst = KSWZ(sr, sc * 16), krst = KSWZ(sr, 128 + sc * 16);
  const int vb0 = (int)(uintptr_t)ring + SHM_K + v_rd_base(lane);
  const bf16_t* kvp = KV + (size_t)sr * LDKV + h * 128 + sc * 8; const bf16_t* krp = KR + (size_t)sr * LDKR + (sc & 3) * 8;
  bf16x8 kn0, vv0, kr0, kn1, vv1, kr1;
#define TROW(t) ((t) == 0 ? META_ROW0 : kvrow0 + ((t) - 1) * KVBLK)
#define TCL(t) ((t) < NT ? (t) : NT - 1)
#define SLOAD0(t) do { const size_t rb_ = (size_t)TROW(t); kn0 = ld8(kvp + rb_ * LDKV); vv0 = ld8(kvp + rb_ * LDKV + 64); kr0 = ld8(krp + rb_ * LDKR); } while (0)
#define SLOAD1(t) do { const size_t rb_ = (size_t)TROW(t); kn1 = ld8(kvp + rb_ * LDKV); vv1 = ld8(kvp + rb_ * LDKV + 64); kr1 = ld8(krp + rb_ * LDKR); } while (0)
#define SWRITE0(off) do { *(bf16x8*)(ring + (off) + vst) = vv0; *(bf16x8*)(ring + (off) + kst) = kn0; if (sc < 4) *(bf16x8*)(ring + (off) + krst) = kr0; } while (0)
#define SWRITE1(off) do { *(bf16x8*)(ring + (off) + vst) = vv1; *(bf16x8*)(ring + (off) + kst) = kn1; if (sc < 4) *(bf16x8*)(ring + (off) + krst) = kr1; } while (0)
#define SWAIT() asm volatile("s_waitcnt vmcnt(3)" ::: "memory")
#define RESC(a) do { if (__any((a) < 1.f)) { if (hi == 0) al_l[r32] = (a); asm volatile("s_waitcnt lgkmcnt(0)" ::: "memory"); \
    _Pragma("unroll") for (int d = 0; d < 2; ++d) _Pragma("unroll") for (int r = 0; r < 16; ++r) o[d][r] *= al_l[crow(r, hi)]; } } while (0)
  f32x16 p0, p1; float mn, al; bf16x8 pa0, pa1, pa2, pa3;
  p0 = f32x16{}; p1 = f32x16{}; pa0 = bf16x8{}; pa1 = pa0; pa2 = pa0; pa3 = pa0;
#define PVSEG(bp) pv_d0(o, vb0 + (bp), pa0, pa1, pa2, pa3)
#define QKSEG(bc) qkt(p0, p1, ring + (bc), qr, r32, hi)
#define SSEG() do { partialSM(p0, p1, m_reg, mn, al); RESC(al); finishSM(p0, p1, al, l_reg, pa0, pa1, pa2, pa3); } while (0)
  SLOAD0(0); asm volatile("s_waitcnt vmcnt(0)" ::: "memory"); SWRITE0(0);
  SLOAD1(1); SLOAD0(2);
  __syncthreads();
  if (!grpA) __syncthreads();
  int bprev = 0, bcur = SLOT, bnext = 2 * SLOT;
  SWAIT(); SWRITE1(SLOT); SLOAD1(TCL(3)); SBAR();
  QKSEG(0);
  __syncthreads();
#pragma unroll
  for (int r = 8; r < 16; ++r) p0[r] = -INFINITY;
#pragma unroll
  for (int r = 0; r < 16; ++r) p1[r] = -INFINITY;
  SSEG();
  __syncthreads();
#define ROT() do { const int t_ = bprev; bprev = bcur; bcur = bnext; bnext = t_; } while (0)
  for (int t = 1; t < NT; t += 2) {
    SWAIT(); SWRITE0(bnext); SLOAD0(TCL(t + 3)); SBAR();
    PVSEG(bprev); QKSEG(bcur);
    __syncthreads();
    SSEG();
    __syncthreads();
    ROT();
    SWAIT(); SWRITE1(bnext); SLOAD1(TCL(t + 4)); SBAR();
    PVSEG(bprev); QKSEG(bcur);
    __syncthreads();
    SSEG();
    __syncthreads();
    ROT();
  }
  PVSEG(bprev);
  __syncthreads();
  __syncthreads();
  if (grpA) __syncthreads();
  if (hi == 0) li_l[r32] = l_reg; asm volatile("s_waitcnt lgkmcnt(0)" ::: "memory");
  float rli[16];
#pragma unroll
  for (int r = 0; r < 16; ++r) rli[r] = __builtin_amdgcn_rcpf(li_l[crow(r, hi)]);
  bf16_t* Ow = O + (size_t)(qrow0 + wid * QBLK) * LDO + 512 + h * 64;
#pragma unroll
  for (int r = 0; r < 16; ++r) { const int orow = crow(r, hi);
#pragma unroll
    for (int d0 = 0; d0 < 2; ++d0) { const unsigned w = cvtpk(o[d0][r] * rli[r], 0.f); Ow[(size_t)orow * LDO + d0 * 32 + r32] = (bf16_t)(w & 0xffffu); } }
  asm volatile("s_waitcnt vmcnt(0)" ::: "memory");
  __syncthreads();
#undef TROW
#undef TCL
#undef SLOAD0
#undef SLOAD1
#undef SWRITE0
#undef SWRITE1
#undef SWAIT
#undef RESC
#undef PVSEG
#undef QKSEG
#undef SSEG
#undef ROT
}
__device__ __forceinline__ void attn_phase(const bf16_t* Q, const bf16_t* KV, const bf16_t* KR, bf16_t* O, int vcu, int G, char* lds) {
  for (int u = vcu; u < 1536; u += G) {
    int qrow0, kvrow0, NT, h;
    if (u < 512) { const int sh = u >> 4, qb = u & 15, seq = sh >> 3; h = sh & 7; kvrow0 = seq * 4096; qrow0 = kvrow0 + qb * 256; NT = 65; }
    else { const int v = u - 512, sh = v >> 3, qb = v & 7, seq = sh >> 3; h = sh & 7; kvrow0 = 16384 + seq * 2048; qrow0 = kvrow0 + qb * 256; NT = 33; }
    attn_unit(Q, KV, KR, O, qrow0, kvrow0, NT, h, lds);
  }
}
#undef KSWZ
#undef SBAR
}
#ifndef MK_N_LAUNCHES
#define MK_N_LAUNCHES 1
#endif
constexpr int N_LAUNCHES = MK_N_LAUNCHES;
constexpr int N_PHASES = 10;
#define LAS __attribute__((address_space(3)))
typedef unsigned short bf16;
typedef unsigned v4u __attribute__((ext_vector_type(4)));
typedef float f32x4 __attribute__((ext_vector_type(4)));
constexpr int DM = 1024, DFF = 2816, NREAL = 49152, MALLR = 49408, NPROMPT = 16384, NGU = 2 * DFF, NINP = 2304, DIN = 2208;
constexpr int NWAVES = 8;
constexpr size_t SZ_WGU = (size_t)NGU * DM * 2, SZ_WD = (size_t)DM * DFF * 2;
constexpr size_t WS_WGU1 = 0, WS_WD1 = WS_WGU1 + SZ_WGU, WS_WGU2 = WS_WD1 + SZ_WD, WS_WD2 = WS_WGU2 + SZ_WGU;
constexpr size_t WS_WIN = WS_WD2 + SZ_WD, WS_WUQ = WS_WIN + (size_t)NINP * DM * 2, WS_WUKV = WS_WUQ + (size_t)768 * 384 * 2, WS_WOUT = WS_WUKV + (size_t)1024 * 256 * 2;
constexpr size_t WS_XN = WS_WOUT + (size_t)DM * DM * 2;
constexpr size_t WS_H = WS_XN + (size_t)MALLR * DM * 2;
constexpr size_t SZ_H = (size_t)MALLR * DFF * 2;
constexpr size_t WS_U = WS_H, WS_QL = WS_U + (size_t)MALLR * 512 * 2, WS_KVL = WS_QL + (size_t)MALLR * 384 * 2, WS_KR = WS_KVL + (size_t)MALLR * 256 * 2, WS_Q = WS_KR + (size_t)MALLR * 32 * 2;
static_assert(WS_Q + (size_t)NREAL * 768 * 2 <= WS_H + SZ_H, "overlay fits in h");
constexpr size_t WS_MIX = WS_H + SZ_H;
constexpr size_t WS_SSA = WS_MIX + (size_t)NREAL * DM * 2;
constexpr size_t WS_SSB = WS_SSA + (size_t)MALLR * 16 * 4;
constexpr size_t WS_ROPE = WS_SSB + (size_t)MALLR * 32 * 4;
constexpr size_t WS_CTL = WS_ROPE + (size_t)4112 * 16 * 8, CTL_BYTES = 65536;
constexpr size_t WS_END = WS_CTL + CTL_BYTES;
static_assert(WS_END <= 536870912ull, "d_ws map exceeds 512 MiB");
static_assert(WS_CTL % 256 == 0 && WS_WD1 % 256 == 0 && WS_WIN % 256 == 0 && WS_XN % 256 == 0 && WS_H % 256 == 0 && WS_MIX % 256 == 0 && WS_SSA % 256 == 0 && WS_ROPE % 256 == 0 && WS_Q % 256 == 0 && WS_KR % 256 == 0, "alignment");
constexpr int LDS_BYTES = 139264;
constexpr int MISC_OFF = pg8::STAGE_BYTES;
static_assert(att::SHM_ATTN <= pg8::STAGE_BYTES && MISC_OFF + 256 <= LDS_BYTES, "LDS");

#define LDS_WAIT() asm volatile("s_waitcnt lgkmcnt(0)" ::: "memory")
__device__ __forceinline__ unsigned f2bf(float f) { unsigned u = __builtin_bit_cast(unsigned, f); return (u + 0x7fffu + ((u >> 16) & 1u)) >> 16; }
__device__ __forceinline__ unsigned pk2(float lo, float hi) { return f2bf(lo) | (f2bf(hi) << 16); }
__device__ __forceinline__ float bflo(unsigned w) { return __builtin_bit_cast(float, w << 16); }
__device__ __forceinline__ float bfhi(unsigned w) { return __builtin_bit_cast(float, w & 0xffff0000u); }
__device__ __forceinline__ float wave_sum(float v) {
#pragma unroll
    for (int o = 1; o < 64; o <<= 1) v += __shfl_xor(v, o);
    return v;
}
__device__ __forceinline__ void p0_transpose_item(const float* W, int K, int N, bf16* WT, int k0, int n0, int drow0, LAS float* scr, int lane, const float* gk = nullptr) {
#pragma unroll 8
    for (int i = 0; i < 32; ++i) { const int kk = 2 * i + (lane >> 5); const float gsc = gk ? gk[k0 + kk] : 1.0f; scr[kk * 33 + (lane & 31)] = W[(size_t)(k0 + kk) * N + n0 + (lane & 31)] * gsc; }
    LDS_WAIT(); asm volatile("" ::: "memory");
    const int c = lane & 7;
#pragma unroll
    for (int j = 0; j < 4; ++j) { const int n = (lane >> 3) + 8 * j; const LAS float* s = scr + (8 * c) * 33 + n;
        v4u o; o.x = pk2(s[0 * 33], s[1 * 33]); o.y = pk2(s[2 * 33], s[3 * 33]); o.z = pk2(s[4 * 33], s[5 * 33]); o.w = pk2(s[6 * 33], s[7 * 33]);
        *(v4u*)(WT + (size_t)(drow0 + n) * K + k0 + 8 * c) = o; }
    LDS_WAIT(); asm volatile("" ::: "memory");
}
__device__ __forceinline__ int map_gu(int n0, int up) { return (n0 >> 7) * 256 + up * 128 + (n0 & 127); }
__device__ __forceinline__ int map_win(int n0) {
    if (n0 < 512) return n0;
    if (n0 < 1024) { const int t = n0 - 512; return 512 + (t >> 7) * 256 + (t & 127); }
    if (n0 < 1536) { const int t = n0 - 1024; return 512 + (t >> 7) * 256 + 128 + (t & 127); }
    return n0;
}

typedef __attribute__((address_space(1))) unsigned gu32;
#define RLX_AGENT __ATOMIC_RELAXED, __HIP_MEMORY_SCOPE_AGENT
#define XB_TMO      128
#define XB_XCNT(j)  (256  + 64 * (j))
#define XB_XSUB(j)  (1280 + 64 * (j))
#define XB_XGEN(j)  (2304 + 64 * (j))
#define XB_TOP      3328
#define XB_TOPGEN   3392
#define XCD_BAR_WORDS 3456
#define XB_SPIN_CAP (1u << 18)

__device__ __forceinline__ unsigned xb_ld(unsigned* p)              { return __hip_atomic_load(p, __ATOMIC_RELAXED, __HIP_MEMORY_SCOPE_AGENT); }
__device__ __forceinline__ unsigned xb_add(unsigned* p, unsigned v) { return __hip_atomic_fetch_add(p, v, __ATOMIC_RELAXED, __HIP_MEMORY_SCOPE_AGENT); }
__device__ __forceinline__ unsigned xb_xcc_id() { return (unsigned)__builtin_amdgcn_s_getreg((3 << 11) | 20) & 0xFu; }
#define XB_SPIN(cond, bar) do { unsigned _sp = 0; while (cond) { __builtin_amdgcn_s_sleep(1); \
    if ((++_sp & 255u) == 0u) { if (xb_ld(&(bar)[XB_TMO])) break; if (_sp > XB_SPIN_CAP) { atomicAdd(&(bar)[XB_TMO], 1u); break; } } } } while (0)

struct XcdBarrier {
    unsigned* bar; unsigned x;
    volatile LAS unsigned* st;
};

__device__ __forceinline__ XcdBarrier xcd_barrier_post(unsigned* bar, volatile LAS unsigned* st) {
    XcdBarrier b; b.bar = bar; b.x = xb_xcc_id(); b.st = st;
    if (threadIdx.x == 0) (void)xb_add(&bar[XB_XCNT(b.x)], 1u);
    return b;
}
__device__ __forceinline__ void xcd_barrier_complete(unsigned* bar, unsigned x, unsigned& nloc, unsigned& nx) {
    const unsigned G = gridDim.x * gridDim.y * gridDim.z;
    unsigned sum, cnt, mine, sp = 0u;
    for (;;) {
        sum = 0u; cnt = 0u; mine = 0u;
#pragma unroll
        for (unsigned j = 0; j < 16; ++j) { const unsigned c = xb_ld(&bar[XB_XCNT(j)]); sum += c; cnt += (c > 0u) ? 1u : 0u; mine = (j == x) ? c : mine; }
        if (sum == G) break;
        __builtin_amdgcn_s_sleep(1);
        if ((++sp & 255u) == 0u) { if (xb_ld(&bar[XB_TMO])) break; if (sp > XB_SPIN_CAP) { atomicAdd(&bar[XB_TMO], 1u); break; } }
    }
    nloc = mine > 0u ? mine : 1u; nx = cnt > 0u ? cnt : 1u;
}

__device__ __forceinline__ void xcd_barrier(const XcdBarrier& b) {
    asm volatile("s_waitcnt vmcnt(0)" ::: "memory");
    __syncthreads();
    if (threadIdx.x == 0) {
        unsigned* bar = b.bar;
        __builtin_amdgcn_s_waitcnt(0);
        unsigned nloc = b.st[0], nx = b.st[1];
        if (nloc == 0u) { xcd_barrier_complete(bar, b.x, nloc, nx); b.st[0] = nloc; b.st[1] = nx; }
        const unsigned old = xb_add(&bar[XB_XSUB(b.x)], 1u);
        const unsigned gen = old / nloc;
        if (old + 1u == (gen + 1u) * nloc) {
            __builtin_amdgcn_fence(__ATOMIC_RELEASE, "agent");
            asm volatile("s_waitcnt vmcnt(0)" ::: "memory");
            const unsigned og = xb_add(&bar[XB_TOP], 1u);
            const unsigned tg = og / nx;
            if (og + 1u == (tg + 1u) * nx) xb_add(&bar[XB_TOPGEN], 1u);
            else XB_SPIN(xb_ld(&bar[XB_TOPGEN]) == tg, bar);
            __builtin_amdgcn_fence(__ATOMIC_ACQUIRE, "agent");
            xb_add(&bar[XB_XGEN(b.x)], 1u);
            asm volatile("s_waitcnt vmcnt(0)" ::: "memory");
        } else {
            XB_SPIN(xb_ld(&bar[XB_XGEN(b.x)]) == gen, bar);
            __builtin_amdgcn_fence(__ATOMIC_ACQUIRE, "agent");
            asm volatile("s_waitcnt vmcnt(0)" ::: "memory");
        }
    }
    __syncthreads();
}
constexpr int CW_CONV = 8192;
struct Args { const float* in[20]; float* out; unsigned char* ws; int ph_lo, ph_hi; };

__global__ void __launch_bounds__(NWAVES * 64, 2) mk_fwd(Args args) {
    extern __shared__ __attribute__((aligned(16))) unsigned char lds[];
    cg::grid_group grid = cg::this_grid();
    const int tid = threadIdx.x, lane = tid & 63, wave = __builtin_amdgcn_readfirstlane(tid >> 6);
    const int G = gridDim.x, bx = blockIdx.x, vcu = (G % 8 == 0) ? (bx % 8) * (G / 8) + bx / 8 : bx;
    const int gw = vcu * NWAVES + wave, NGW = G * NWAVES;
    unsigned char* ws = args.ws;
    const float* x_prompt = args.in[0]; const float* x_sample = args.in[1]; const float* meta = args.in[2];
    bf16* WGU1 = (bf16*)(ws + WS_WGU1); bf16* WD1 = (bf16*)(ws + WS_WD1); bf16* WGU2 = (bf16*)(ws + WS_WGU2); bf16* WD2 = (bf16*)(ws + WS_WD2);
    bf16* WIN = (bf16*)(ws + WS_WIN); bf16* WUQ = (bf16*)(ws + WS_WUQ); bf16* WUKV = (bf16*)(ws + WS_WUKV); bf16* WOUT = (bf16*)(ws + WS_WOUT);
    bf16* XN = (bf16*)(ws + WS_XN); bf16* KVB = XN; bf16* HB = (bf16*)(ws + WS_H); bf16* UB = (bf16*)(ws + WS_U); bf16* QL = (bf16*)(ws + WS_QL); bf16* KVL = (bf16*)(ws + WS_KVL);
    bf16* KR = (bf16*)(ws + WS_KR); bf16* QB = (bf16*)(ws + WS_Q); bf16* MIX = (bf16*)(ws + WS_MIX);
    float* SSA = (float*)(ws + WS_SSA); float* SSM = SSA + (size_t)MALLR * 4;
    float* SSB = (float*)(ws + WS_SSB); float* ROPE = (float*)(ws + WS_ROPE);
    float* out = args.out;
    bf16* X1B = (bf16*)args.out;
    LAS unsigned char* ldsl = (LAS unsigned char*)lds;
    const int lo = args.ph_lo, hi = args.ph_hi;
    volatile LAS unsigned* MISC = (volatile LAS unsigned*)(ldsl + MISC_OFF);
    if (tid < 64) MISC[tid] = 0u;
    __syncthreads();
    XcdBarrier bar; bar.bar = (unsigned*)(ws + WS_CTL); bar.x = 0; bar.st = nullptr;
    if (N_LAUNCHES == 1) bar = xcd_barrier_post((unsigned*)(ws + WS_CTL), MISC + 8);
#ifdef ONLYMASK
#define IN(k) (((ONLYMASK >> (k)) & 1) && lo <= (k) && (k) < hi)
#else
#define IN(k) (lo <= (k) && (k) < hi)
#endif
#define SEAM(k) do { if (IN(k) && IN((k) + 1)) { if (lo < 0) grid.sync(); else xcd_barrier(bar); } } while (0)
#ifndef DUP_MASK
#define DUP_MASK 0
#endif
#define REP(k) for (int rep_ = 0; rep_ < 1 + ((DUP_MASK >> (k)) & 1); ++rep_)

    constexpr int I_G = 16 * 88, I_D = 44 * 32, I_IN = 16 * 69, I_UQ = 6 * 24, I_UKV = 4 * 32, I_O = 16 * 32;
    constexpr int NITEMS = 4 * I_G + 2 * I_D + I_IN + I_UQ + I_UKV + I_O;
    const int NOW_ITEMS = (G == 256) ? 2 * I_G : NITEMS;
    LAS float* scr = (LAS float*)(ldsl + wave * 16384);
#define CONVERT_ITEMS(FIRST, LAST, WIDX, WSTRIDE) do { \
        for (int it = (FIRST) + (WIDX); it < (LAST); it += (WSTRIDE)) { \
            int r = it; \
            if (r < 4 * I_G) { const int which = r / I_G, q = r % I_G, kb = q / 88, nb = q % 88; \
                const float* W = args.in[which == 0 ? 4 : which == 1 ? 5 : which == 2 ? 16 : 17]; \
                p0_transpose_item(W, DM, DFF, which < 2 ? WGU1 : WGU2, 64 * kb, 32 * nb, map_gu(32 * nb, which & 1), scr, lane, args.in[which < 2 ? 3 : 15]); continue; } \
            r -= 4 * I_G; \
            if (r < 2 * I_D) { const int which = r / I_D, q = r % I_D, kb = q / 32, nb = q % 32; \
                p0_transpose_item(args.in[which ? 18 : 6], DFF, DM, which ? WD2 : WD1, 64 * kb, 32 * nb, 32 * nb, scr, lane); continue; } \
            r -= 2 * I_D; \
            if (r < I_IN) { const int kb = r / 69, nb = r % 69; p0_transpose_item(args.in[8], DM, DIN, WIN, 64 * kb, 32 * nb, map_win(32 * nb), scr, lane, args.in[7]); continue; } \
            r -= I_IN; \
            if (r < I_UQ) { const int kb = r / 24, nb = r % 24; p0_transpose_item(args.in[11], 384, 768, WUQ, 64 * kb, 32 * nb, 32 * nb, scr, lane); continue; } \
            r -= I_UQ; \
            if (r < I_UKV) { const int kb = r / 32, nb = r % 32; p0_transpose_item(args.in[13], 256, 1024, WUKV, 64 * kb, 32 * nb, 32 * nb, scr, lane); continue; } \
            r -= I_UKV; \
            { const int kb = r / 32, nb = r % 32; p0_transpose_item(args.in[14], DM, DM, WOUT, 64 * kb, 32 * nb, 32 * nb, scr, lane); } \
        } \
    } while (0)
    if (IN(0)) REP(0) {
        CONVERT_ITEMS(0, NOW_ITEMS, gw, NGW);
        for (int i = gw * 64 + lane; i < 96 * DM / 8; i += NGW * 64) ((v4u*)(WIN + (size_t)DIN * DM))[i] = (v4u){0u, 0u, 0u, 0u};
        for (int i = gw * 64 + lane; i < 4112 * 16; i += NGW * 64) { const int pos = i >> 4, j = i & 15;
            const double b4 = (j & 3) == 0 ? 1.0 : (j & 3) == 1 ? 0.5623413251903491 : (j & 3) == 2 ? 0.31622776601683794 : 0.1778279410038923;
            const double p10 = (j >> 2) == 0 ? 1.0 : (j >> 2) == 1 ? 0.1 : (j >> 2) == 2 ? 0.01 : 0.001;
            const double rev = (double)pos * (b4 * p10) * 0.15915494309189535; const float fr = (float)(rev - __builtin_floor(rev));
            ROPE[2 * i] = __builtin_amdgcn_cosf(fr); ROPE[2 * i + 1] = __builtin_amdgcn_sinf(fr); }
        for (int i = gw * 64 + lane; i < 240 * DM / 8; i += NGW * 64) ((v4u*)(X1B + (size_t)(NREAL + 16) * DM))[i] = (v4u){0u, 0u, 0u, 0u};
        for (int m0 = gw; m0 < MALLR; m0 += 2 * NGW) {
            f32x4 v[2][4]; bool live[2];
#pragma unroll
            for (int k = 0; k < 2; ++k) { const int m = m0 + k * NGW; live[k] = m < MALLR;
                const float* src = m < NPROMPT ? x_prompt + (size_t)m * DM : (m < NREAL ? x_sample + (size_t)(m - NPROMPT) * DM : meta + (size_t)((m - NREAL) & 15) * DM);
                const bool have = m < NREAL + 16;
#pragma unroll
                for (int j = 0; j < 4; ++j) v[k][j] = have ? ((const f32x4*)src)[lane + 64 * j] : (f32x4){0.f, 0.f, 0.f, 0.f}; }
#pragma unroll
            for (int k = 0; k < 2; ++k) { if (!live[k]) continue; const int m = m0 + k * NGW; float s = 0.f;
#pragma unroll
                for (int j = 0; j < 4; ++j) s += (v[k][j][0] * v[k][j][0] + v[k][j][1] * v[k][j][1]) + (v[k][j][2] * v[k][j][2] + v[k][j][3] * v[k][j][3]);
                s = wave_sum(s);
                const float rs0 = __builtin_amdgcn_rsqf(s * (1.0f / 1024.0f) + 1e-6f);
                unsigned long long* o8 = (unsigned long long*)(XN + (size_t)m * DM) + lane;
#pragma unroll
                for (int j = 0; j < 4; ++j) o8[64 * j] = (unsigned long long)pk2(v[k][j][0] * rs0, v[k][j][1] * rs0) | ((unsigned long long)pk2(v[k][j][2] * rs0, v[k][j][3] * rs0) << 32);
                if (m >= NREAL && lane < 16) SSM[(size_t)(m - NREAL) * 16 + lane] = 0.f; }
        }
    }
    SEAM(0);
    if (IN(1)) REP(1) { pg8::Gemm g{XN, WGU1, MALLR, NGU, DM}; pg8::StaticOrder S; S.init(MALLR, NGU, G, bx);
        pg8::EpiGateUpT<true> E{HB, SSA};
        pg8::gemm_phase<pg8::EpiGateUpT<true>, pg8::StaticOrder, true, true>(ldsl, g, S, E);
        if (G == 256 && bx >= 150) CONVERT_ITEMS(2 * I_G, NITEMS, (bx - 150) * NWAVES + wave, 106 * NWAVES); }
    SEAM(1);
    if (IN(2)) REP(2) {
        if (vcu < 16) {
            typedef short bf16x8s __attribute__((ext_vector_type(8)));
            const int quad = lane >> 4, l15 = lane & 15, kbeg = wave * 352;
            const bf16* ap = HB + (size_t)(NREAL + l15) * DFF + kbeg + 8 * quad;
            const bf16* bp = WD1 + (size_t)(64 * vcu + l15) * DFF + kbeg + 8 * quad;
            f32x4 macc[4];
#pragma unroll
            for (int c = 0; c < 4; ++c) macc[c] = (f32x4){0.f, 0.f, 0.f, 0.f};
#pragma unroll
            for (int st = 0; st < 11; ++st) { const bf16x8s a = *(const bf16x8s*)(ap + 32 * st);
#pragma unroll
                for (int c = 0; c < 4; ++c) { const bf16x8s b = *(const bf16x8s*)(bp + (size_t)c * 16 * DFF + 32 * st); macc[c] = __builtin_amdgcn_mfma_f32_16x16x32_bf16(a, b, macc[c], 0, 0, 0); } }
            LAS f32x4* red = (LAS f32x4*)ldsl;
#pragma unroll
            for (int c = 0; c < 4; ++c) red[(wave * 4 + c) * 64 + lane] = macc[c];
            __syncthreads();
            if (wave == 0) {
                float ssr[4] = {0.f, 0.f, 0.f, 0.f};
#pragma unroll
                for (int c = 0; c < 4; ++c) { f32x4 t = red[c * 64 + lane];
#pragma unroll
                    for (int w = 1; w < 8; ++w) t += red[(w * 4 + c) * 64 + lane];
                    const int col = 64 * vcu + 16 * c + l15;
#pragma unroll
                    for (int i = 0; i < 4; ++i) { const int row = 4 * quad + i; const float xv = meta[(size_t)row * DM + col] + 0.5f * t[i]; ssr[i] += xv * xv;
                        X1B[(size_t)(NREAL + row) * DM + col] = (bf16)f2bf(xv); } }
#pragma unroll
                for (int i = 0; i < 4; ++i) { float sv = ssr[i]; sv += __shfl_xor(sv, 1); sv += __shfl_xor(sv, 2); sv += __shfl_xor(sv, 4); sv += __shfl_xor(sv, 8);
                    if (l15 == 0) SSM[(size_t)(4 * quad + i) * 16 + vcu] = sv; }
            }
            __syncthreads();
        }
        pg8::Gemm g{HB, WD1, NREAL, DM, DFF}; pg8::StaticOrder S; S.init(NREAL, DM, G, bx);
        pg8::EpiResidB<0> E{x_prompt, x_sample, nullptr, X1B, SSA, 0.5f};
        pg8::gemm_phase<pg8::EpiResidB<0>, pg8::StaticOrder, true, true>(ldsl, g, S, E); }
    SEAM(2);
    if (IN(3)) REP(3) { pg8::Gemm g{X1B, WIN, MALLR, NINP, DM}; pg8::StaticOrder S; S.init(MALLR, NINP, G, bx);
        pg8::EpiWin E{SSA, MIX, UB, QL, KVL, KR, SSB, args.in[10], args.in[12], ROPE};
        pg8::gemm_phase<pg8::EpiWin, pg8::StaticOrder, true, true>(ldsl, g, S, E); }
    SEAM(3);
    if (IN(4)) {
#ifndef P4_SKIP_Q
        { int kq = 384; asm volatile("" : "+s"(kq)); pg8::Gemm g{QL, WUQ, NREAL, 768, kq}; pg8::StaticOrder S; S.init(NREAL, 768, G, bx);
          pg8::EpiQup E{SSB, QB, ROPE};
          pg8::gemm_phase<pg8::EpiQup, pg8::StaticOrder, true, true>(ldsl, g, S, E); }
#endif
#ifndef P4_SKIP_KV
        if (gw < 64) {
            typedef short bf16x8s __attribute__((ext_vector_type(8)));
            const int quad = lane >> 4, l15 = lane & 15;
            const bf16* ap = KVL + (size_t)(NREAL + l15) * 256 + 8 * quad; const bf16* bp = WUKV + (size_t)(16 * gw + l15) * 256 + 8 * quad;
            f32x4 kacc = (f32x4){0.f, 0.f, 0.f, 0.f};
#pragma unroll
            for (int st = 0; st < 8; ++st) kacc = __builtin_amdgcn_mfma_f32_16x16x32_bf16(*(const bf16x8s*)(ap + 32 * st), *(const bf16x8s*)(bp + 32 * st), kacc, 0, 0, 0);
#pragma unroll
            for (int i = 0; i < 4; ++i) { const size_t row = (size_t)NREAL + 4 * quad + i; const f32x4* sp = (const f32x4*)(SSB + row * 32 + 12); const f32x4 v0 = sp[0], v1 = sp[1];
                const float sv = ((v0[0] + v0[1]) + (v0[2] + v0[3])) + ((v1[0] + v1[1]) + (v1[2] + v1[3]));
                KVB[row * DM + 16 * gw + l15] = (bf16)f2bf(kacc[i] * __builtin_amdgcn_rsqf(sv * (1.0f / 256.0f) + 1e-6f)); }
        }
        { int kk = 256; asm volatile("" : "+s"(kk)); pg8::Gemm g{KVL, WUKV, NREAL, 1024, kk}; pg8::StaticOrder S; S.init(NREAL, 1024, G, bx);
          pg8::EpiKVup E{SSB, KVB};
          pg8::gemm_phase<pg8::EpiKVup, pg8::StaticOrder, true, true>(ldsl, g, S, E); }
#endif
#ifndef P4_SKIP_CONV
        const float* cw = args.in[9];
        f32x4 w0a = ((const f32x4*)cw)[2 * lane], w0b = ((const f32x4*)cw)[2 * lane + 1], w1a = ((const f32x4*)(cw + 512))[2 * lane], w1b = ((const f32x4*)(cw + 512))[2 * lane + 1],
              w2a = ((const f32x4*)(cw + 1024))[2 * lane], w2b = ((const f32x4*)(cw + 1024))[2 * lane + 1];
        int cbeg, cend, cstep;
        if (G == 256) { cbeg = (bx < 64 ? bx * 120 : 7680 + (bx - 64) * 216); cend = cbeg + (bx < 64 ? 120 : 216); cbeg += wave; cstep = NWAVES; }
        else { cbeg = gw; cend = NREAL; cstep = NGW; }
        {
          for (int m = cbeg; m < cend; m += cstep) {
            const int t = m < NPROMPT ? (m & 4095) : ((m - NPROMPT) & 2047), L = m < NPROMPT ? 4096 : 2048;
            const v4u uc = *((const v4u*)(UB + (size_t)m * 512) + lane);
            const v4u up = *((const v4u*)(UB + (size_t)(t == 0 ? NREAL + 15 : m - 1) * 512) + lane);
            v4u un = (v4u){0u, 0u, 0u, 0u}; if (t != L - 1) un = *((const v4u*)(UB + (size_t)(m + 1) * 512) + lane);
            v4u* bp = (v4u*)(MIX + (size_t)m * DM) + lane; const v4u b = *bp; v4u y;
#define CONV2(k, WA0, WA1, WB0, WB1, WC0, WC1) y[k] = pk2(bflo(b[k]) * (WA0 * bflo(up[k]) + WB0 * bflo(uc[k]) + WC0 * bflo(un[k])), bfhi(b[k]) * (WA1 * bfhi(up[k]) + WB1 * bfhi(uc[k]) + WC1 * bfhi(un[k])))
            CONV2(0, w0a[0], w0a[1], w1a[0], w1a[1], w2a[0], w2a[1]); CONV2(1, w0a[2], w0a[3], w1a[2], w1a[3], w2a[2], w2a[3]);
            CONV2(2, w0b[0], w0b[1], w1b[0], w1b[1], w2b[0], w2b[1]); CONV2(3, w0b[2], w0b[3], w1b[2], w1b[3], w2b[2], w2b[3]);
#undef CONV2
            *bp = y;
          }
        }
#endif
    }
    SEAM(4);
    if (IN(5)) REP(5) att::attn_phase(QB, KVB, KR, MIX, vcu, G, (char*)lds);
    SEAM(5);
    if (IN(6)) { pg8::Gemm g{MIX, WOUT, NREAL, DM, DM}; pg8::StaticOrder S; S.init(NREAL, DM, G, bx);
        pg8::EpiResidB<1> E{nullptr, nullptr, X1B, XN, SSA, 1.0f};
        pg8::gemm_phase<pg8::EpiResidB<1>, pg8::StaticOrder, true, true>(ldsl, g, S, E); }
    SEAM(6);
    if (IN(7)) { pg8::Gemm g{XN, WGU2, NREAL, NGU, DM}; pg8::StaticOrder S; S.init(NREAL, NGU, G, bx);
        pg8::EpiGateUp E{HB, SSA};
        pg8::gemm_phase<pg8::EpiGateUp, pg8::StaticOrder, true, true>(ldsl, g, S, E); }
    SEAM(7);
    if (IN(8)) { pg8::Gemm g{HB, WD2, NREAL, DM, DFF}; pg8::StaticOrder S; S.init(NREAL, DM, G, bx);
        pg8::EpiResidB<1> E{nullptr, nullptr, XN, XN, SSA, 0.5f};
        pg8::gemm_phase<pg8::EpiResidB<1>, pg8::StaticOrder, true, true>(ldsl, g, S, E); }
    SEAM(8);
    if (IN(9)) {
        const float* gf = args.in[19];
        f32x4 gq[4];
#pragma unroll
        for (int j = 0; j < 4; ++j) gq[j] = ((const f32x4*)gf)[(j >> 1) * 128 + 2 * lane + (j & 1)];
        for (int m0 = gw; m0 < NREAL; m0 += 4 * NGW) {
            v4u xa[4], xb[4]; float sv[4];
#pragma unroll
            for (int k = 0; k < 4; ++k) { const int m = m0 + k * NGW < NREAL ? m0 + k * NGW : m0;
                { const f32x4 s4 = *(const f32x4*)(SSA + (size_t)m * 4); sv[k] = (s4[0] + s4[1]) + (s4[2] + s4[3]); }
                const v4u* xr = (const v4u*)(XN + (size_t)m * DM); xa[k] = xr[lane]; xb[k] = xr[64 + lane]; }
#pragma unroll
            for (int k = 0; k < 4; ++k) { const int m = m0 + k * NGW; if (m >= NREAL) continue;
                const float rs = __builtin_amdgcn_rsqf(sv[k] * (1.0f / 1024.0f) + 1e-6f);
                f32x4* p = (f32x4*)(out + (size_t)m * DM);
                p[2 * lane] = (f32x4){bflo(xa[k][0]), bfhi(xa[k][0]), bflo(xa[k][1]), bfhi(xa[k][1])} * rs * gq[0];
                p[2 * lane + 1] = (f32x4){bflo(xa[k][2]), bfhi(xa[k][2]), bflo(xa[k][3]), bfhi(xa[k][3])} * rs * gq[1];
                p[128 + 2 * lane] = (f32x4){bflo(xb[k][0]), bfhi(xb[k][0]), bflo(xb[k][1]), bfhi(xb[k][1])} * rs * gq[2];
                p[128 + 2 * lane + 1] = (f32x4){bflo(xb[k][2]), bfhi(xb[k][2]), bflo(xb[k][3]), bfhi(xb[k][3])} * rs * gq[3]; }
        }
    }
#undef IN
#undef SEAM
}

extern "C" void kernel_launch(void* const* d_in, const int* in_sizes, int n_in, void* d_out, int out_size, void* d_ws, size_t ws_size, hipStream_t stream) {
    static int grid = 0;
    if (grid == 0) {
        if (n_in != 20 || out_size != NREAL * DM || ws_size < WS_END) { fprintf(stderr, "kernel_launch: unexpected shapes: n_in %d out %d ws %zu (need >= %zu)\n", n_in, out_size, ws_size, (size_t)WS_END); grid = -1; return; }
        int dev = 0, cus = 0, per_cu = 0;
        if (hipGetDevice(&dev) != hipSuccess || hipDeviceGetAttribute(&cus, hipDeviceAttributeMultiprocessorCount, dev) != hipSuccess) { fprintf(stderr, "kernel_launch: device query failed\n"); grid = -1; return; }
        if (hipFuncSetAttribute((const void*)mk_fwd, hipFuncAttributeMaxDynamicSharedMemorySize, LDS_BYTES) != hipSuccess) { fprintf(stderr, "kernel_launch: hipFuncSetAttribute failed\n"); grid = -1; return; }
        if (hipOccupancyMaxActiveBlocksPerMultiprocessor(&per_cu, (const void*)mk_fwd, NWAVES * 64, LDS_BYTES) != hipSuccess || per_cu < 1) { fprintf(stderr, "kernel_launch: occupancy query says %d\n", per_cu); per_cu = 1; }
        (void)hipGetLastError();
        grid = cus * 1;
        fprintf(stderr, "kernel_launch: grid %d (cus %d, per_cu %d), ws %zu need %zu\n", grid, cus, per_cu, ws_size, (size_t)WS_END);
    }
    if (grid < 0) return;
    Args a{};
    for (int i = 0; i < 20; ++i) a.in[i] = (const float*)d_in[i];
    a.out = (float*)d_out; a.ws = (unsigned char*)d_ws;
    if (hipMemsetAsync((char*)d_ws + WS_CTL, 0, CTL_BYTES, stream) != hipSuccess) { fprintf(stderr, "kernel_launch: memset failed\n"); return; }
    if (N_LAUNCHES == 1) {
        a.ph_lo = 0; a.ph_hi = N_PHASES;
        void* kargs[] = {&a};
        const hipError_t e = hipLaunchCooperativeKernel((const void*)mk_fwd, dim3(grid), dim3(NWAVES * 64), kargs, LDS_BYTES, stream);
        if (e != hipSuccess) fprintf(stderr, "kernel_launch: cooperative launch failed: %s (grid %d)\n", hipGetErrorString(e), grid);
    } else {
#ifndef PROBE_DUP
#define PROBE_DUP -1
#endif
        for (int p = 0; p < N_PHASES; ++p) for (int rep = 0; rep < (p == PROBE_DUP ? 2 : 1); ++rep) { a.ph_lo = p; a.ph_hi = p + 1;
            hipLaunchKernelGGL(mk_fwd, dim3(grid), dim3(NWAVES * 64), LDS_BYTES, stream, a);
            const hipError_t le = hipPeekAtLastError();
            if (le != hipSuccess) { fprintf(stderr, "kernel_launch: launch %d failed: %s\n", p, hipGetErrorName(le)); break; } }
    }
}
```

```cpp
#include <hip/hip_runtime.h>
#include <hip/hip_bf16.h>
#include <hip/hip_cooperative_groups.h>
#include <cstdio>
#include <cstdint>
#include <cmath>
namespace cg = cooperative_groups;
namespace pg8 {
#define PG8_LAS __attribute__((address_space(3)))
typedef unsigned short bf16_t;
typedef short bf16x8 __attribute__((ext_vector_type(8)));
typedef float f32x4 __attribute__((ext_vector_type(4)));
typedef unsigned u32x4 __attribute__((ext_vector_type(4)));
constexpr int BM = 256, BK = 64, HALF = 128, HTB = HALF * BK * 2  , STAGE_BYTES = 8 * HTB, NXCD = 8, WGM = 8;

__host__ __device__ __forceinline__ int lds_byte(int r, int c) { const int st = (r >> 4) * 2 + (c >> 5), rr = r & 15, cc = c & 31, ob = rr * 64 + cc * 2; return st * 1024 + (ob ^ (((ob >> 9) & 1) << 5)); }
__host__ __device__ __forceinline__ void stage_rc(int b, int& R, int& C) { const int st = b / 1024, sb = b % 1024, swz = sb ^ (((sb >> 9) & 1) << 5); R = (st >> 1) * 16 + swz / 64; C = (st & 1) * 32 + (swz % 64) / 2; }
__host__ __device__ __forceinline__ int perm32(int rho) { const int n = rho >> 4, i = rho & 15; return 8 * (i >> 2) + 4 * n + (i & 3); }

struct Unit { int pm, pn; };
struct Gemm { const bf16_t* A; const bf16_t* Bt; int M, N, K; };

struct StaticOrder {
    int nM, nN, nwg, G, c;
    __host__ __device__ void init(int M, int N, int G_, int c_) { nM = M / BM; nN = N / BM; nwg = nM * nN; G = G_; c = c_; }
    __host__ __device__ bool next(int i, Unit& u) const {
        const long L = (long)i * G + c; if (L >= nwg) return false;
        int wgid = (int)L; { const int q = nwg / NXCD, r = nwg % NXCD, xcd = wgid % NXCD, off = wgid / NXCD; wgid = (xcd < r ? xcd * (q + 1) : r * (q + 1) + (xcd - r) * q) + off; }
        const int nig = WGM * nN, gid = wgid / nig, fm = gid * WGM, gsz = (nM - fm) < WGM ? (nM - fm) : WGM;
        u.pm = fm + ((wgid % nig) % gsz); u.pn = (wgid % nig) / gsz; return true;
    }
    __device__ __forceinline__ void a_ready(const Unit&) const {}
    __device__ __forceinline__ void done(const Unit&) const {}
};

__device__ __forceinline__ unsigned cvt_pk_bf16(float lo, float hi) { unsigned r; asm volatile("v_cvt_pk_bf16_f32 %0, %1, %2" : "=v"(r) : "v"(lo), "v"(hi)); return r; }
typedef float f32x2 __attribute__((ext_vector_type(2)));
constexpr int NREAL = 49152, MALLR = 49408, NPROMPT = 16384;
constexpr float RMS_EPS = 1e-6f;
__device__ __forceinline__ u32x4 pack8(const f32x4 a, const f32x4 b) { u32x4 w; w.x = cvt_pk_bf16(a[0], a[1]); w.y = cvt_pk_bf16(a[2], a[3]); w.z = cvt_pk_bf16(b[0], b[1]); w.w = cvt_pk_bf16(b[2], b[3]); return w; }
__device__ __forceinline__ float fq_sum(float s) {
    auto a = __builtin_amdgcn_permlane16_swap(__float_as_uint(s), __float_as_uint(s), false, false);
    const float t = __uint_as_float(a[0]) + __uint_as_float(a[1]);
    auto b = __builtin_amdgcn_permlane32_swap(__float_as_uint(t), __float_as_uint(t), false, false);
    return __uint_as_float(b[0]) + __uint_as_float(b[1]);
}
__device__ __forceinline__ float row_rstd(const float* ss, int ngrp, int fq, float invn) {
    float s = 0.f;
    if (fq < ngrp) { const f32x4 v = *(const f32x4*)(ss + 4 * fq); s = (v[0] + v[1]) + (v[2] + v[3]); }
    s += __shfl_xor(s, 16); s += __shfl_xor(s, 32);
    return 1.0f / sqrtf(s * invn + RMS_EPS);
}
__device__ __forceinline__ void rows_rstd(float (&rs)[2][4], const float* ss, int stride, int row0, int ngrp, int fq, float invn) {
    f32x4 sv[2][4];
#pragma unroll
    for (int ai = 0; ai < 2; ++ai)
#pragma unroll
        for (int m = 0; m < 4; ++m) { sv[ai][m] = (f32x4){0.f, 0.f, 0.f, 0.f}; if (fq < ngrp) sv[ai][m] = *(const f32x4*)(ss + (size_t)(row0 + ai * HALF + m * 16) * stride + 4 * fq); }
    __builtin_amdgcn_sched_barrier(0);
#pragma unroll
    for (int ai = 0; ai < 2; ++ai)
#pragma unroll
        for (int m = 0; m < 4; ++m) { const float s = fq_sum((sv[ai][m][0] + sv[ai][m][1]) + (sv[ai][m][2] + sv[ai][m][3])); rs[ai][m] = __builtin_amdgcn_rsqf(s * invn + RMS_EPS); }
}
__device__ __forceinline__ void rows_rstd4(float (&rs)[2][4], const float* ss4, int row0, float invn) {
    f32x4 sv[2][4];
#pragma unroll
    for (int ai = 0; ai < 2; ++ai)
#pragma unroll
        for (int m = 0; m < 4; ++m) sv[ai][m] = *(const f32x4*)(ss4 + (size_t)(row0 + ai * HALF + m * 16) * 4);
    __builtin_amdgcn_sched_barrier(0);
#pragma unroll
    for (int ai = 0; ai < 2; ++ai)
#pragma unroll
        for (int m = 0; m < 4; ++m) rs[ai][m] = __builtin_amdgcn_rsqf(((sv[ai][m][0] + sv[ai][m][1]) + (sv[ai][m][2] + sv[ai][m][3])) * invn + RMS_EPS);
}
constexpr int RED_LDS_OFF = 132096;
__device__ __forceinline__ float sumsq8(const f32x4 a, const f32x4 b) { return ((a[0] * a[0] + a[1] * a[1]) + (a[2] * a[2] + a[3] * a[3])) + ((b[0] * b[0] + b[1] * b[1]) + (b[2] * b[2] + b[3] * b[3])); }
__device__ __forceinline__ int rope_pos(int row) { return row < NPROMPT ? (row & 4095) + 16 : (row < NREAL ? ((row - NPROMPT) & 2047) + 16 : ((row - NREAL) & 255)); }
__device__ __forceinline__ void rope8(f32x4& a, f32x4& b, const float* tab  , int pos, int fq) {
    const float* t = tab + ((size_t)pos * 16 + 8 * (fq & 1)) * 2;
    const f32x4 t0 = *(const f32x4*)(t), t1 = *(const f32x4*)(t + 4), t2 = *(const f32x4*)(t + 8), t3 = *(const f32x4*)(t + 12);
    const float sg = (fq < 2) ? -1.f : 1.f;
    f32x4 pa, pb;
#pragma unroll
    for (int k = 0; k < 4; ++k) { auto ra = __builtin_amdgcn_permlane32_swap(__float_as_uint(a[k]), __float_as_uint(a[k]), false, false); auto rb = __builtin_amdgcn_permlane32_swap(__float_as_uint(b[k]), __float_as_uint(b[k]), false, false);
        pa[k] = __uint_as_float(fq < 2 ? ra[1] : ra[0]); pb[k] = __uint_as_float(fq < 2 ? rb[1] : rb[0]); }
    a[0] = a[0] * t0[0] + sg * pa[0] * t0[1]; a[1] = a[1] * t0[2] + sg * pa[1] * t0[3]; a[2] = a[2] * t1[0] + sg * pa[2] * t1[1]; a[3] = a[3] * t1[2] + sg * pa[3] * t1[3];
    b[0] = b[0] * t2[0] + sg * pb[0] * t2[1]; b[1] = b[1] * t2[2] + sg * pb[1] * t2[3]; b[2] = b[2] * t3[0] + sg * pb[2] * t3[1]; b[3] = b[3] * t3[2] + sg * pb[3] * t3[3];
}
__device__ __forceinline__ float silu_mul(float g, float u) { return g * __builtin_amdgcn_rcpf(1.0f + __builtin_amdgcn_exp2f(-1.4426950408889634f * g)) * u; }

template <bool PRENORM> struct EpiGateUpT {
    static constexpr bool PERM = true, AFTER_DRAIN = false;
    bf16_t* H; const float* SS;
    __device__ __forceinline__ void operator()(const f32x4 (&acc)[2][2][4][2], const Unit& u, int wr, int wc, int fr, int fq) const {
        const int row0 = u.pm * BM + wr * 64 + fr, col0 = u.pn * 128 + wc * 32 + 8 * fq;
        float rsv[2][4];
        if (!PRENORM) rows_rstd4(rsv, SS, row0, 1.0f / 1024.0f);
#pragma unroll
        for (int ai = 0; ai < 2; ++ai)
#pragma unroll
            for (int m = 0; m < 4; ++m) { const int row = row0 + ai * HALF + m * 16; const float rs = PRENORM ? 1.0f : rsv[ai][m];
                f32x4 h0, h1;
#pragma unroll
                for (int k = 0; k < 4; ++k) { h0[k] = silu_mul(acc[ai][0][m][0][k] * rs, acc[ai][1][m][0][k] * rs); h1[k] = silu_mul(acc[ai][0][m][1][k] * rs, acc[ai][1][m][1][k] * rs); }
                __builtin_nontemporal_store(pack8(h0, h1), (u32x4*)(H + (size_t)row * 2816 + col0)); }
    }
};
typedef EpiGateUpT<false> EpiGateUp;
template <int SRC, bool WRITE_XN, bool OUT_BF16 = false> struct EpiResid {
    static constexpr bool PERM = true, AFTER_DRAIN = false;
    const float* xp; const float* xs; const float* meta; float* out; bf16_t* XN; const float* gain; float* SS; float alpha;
    __device__ __forceinline__ void operator()(const f32x4 (&acc)[2][2][4][2], const Unit& u, int wr, int wc, int fr, int fq) const {
        const int row0 = u.pm * BM + wr * 64 + fr, col0 = u.pn * BM + wc * 32 + 8 * fq;
        f32x4 gv[2][2];
        if (WRITE_XN) {
#pragma unroll
            for (int bj = 0; bj < 2; ++bj) { gv[bj][0] = *(const f32x4*)(gain + col0 + bj * HALF); gv[bj][1] = *(const f32x4*)(gain + col0 + bj * HALF + 4); } }
#pragma unroll
        for (int ai = 0; ai < 2; ++ai) {
            f32x4 rv[4][2][2];
#pragma unroll
            for (int m = 0; m < 4; ++m) { const int row = row0 + ai * HALF + m * 16;
                const float* src; bool have = true;
                if (SRC == 1) src = out + (size_t)row * 1024;
                else { if (row < NPROMPT) src = xp + (size_t)row * 1024; else if (row < NREAL) src = xs + (size_t)(row - NPROMPT) * 1024; else if (row < NREAL + 16) src = meta + (size_t)(row - NREAL) * 1024; else { src = meta; have = false; } }
#pragma unroll
                for (int bj = 0; bj < 2; ++bj) { const int c = col0 + bj * HALF;
                    rv[m][bj][0] = (f32x4){0.f, 0.f, 0.f, 0.f}; rv[m][bj][1] = rv[m][bj][0];
                    if (have) { rv[m][bj][0] = *(const f32x4*)(src + c); rv[m][bj][1] = *(const f32x4*)(src + c + 4); } } }
            __builtin_amdgcn_sched_barrier(0);
#pragma unroll
            for (int m = 0; m < 4; ++m) { const int row = row0 + ai * HALF + m * 16;
                float ssq = 0.f;
#pragma unroll
                for (int bj = 0; bj < 2; ++bj) { const int c = col0 + bj * HALF;
                    const f32x4 x0 = rv[m][bj][0] + acc[ai][bj][m][0] * alpha, x1 = rv[m][bj][1] + acc[ai][bj][m][1] * alpha;
                    if (OUT_BF16) __builtin_nontemporal_store(pack8(x0, x1), (u32x4*)(XN + (size_t)row * 1024 + c));
                    else if (row < NREAL) { __builtin_nontemporal_store(x0, (f32x4*)(out + (size_t)row * 1024 + c)); __builtin_nontemporal_store(x1, (f32x4*)(out + (size_t)row * 1024 + c + 4)); }
                    ssq += sumsq8(x0, x1);
                    if (WRITE_XN) __builtin_nontemporal_store(pack8(x0 * gv[bj][0], x1 * gv[bj][1]), (u32x4*)(XN + (size_t)row * 1024 + c)); }
                ssq = fq_sum(ssq);
                if (fq == 0) SS[(size_t)row * 16 + u.pn * 4 + wc] = ssq; }
            __builtin_amdgcn_sched_barrier(0);
        }
    }
};
__device__ __forceinline__ f32x4 bf_lo4(const u32x4 w) { return (f32x4){__uint_as_float(w.x << 16), __uint_as_float(w.x & 0xffff0000u), __uint_as_float(w.y << 16), __uint_as_float(w.y & 0xffff0000u)}; }
__device__ __forceinline__ f32x4 bf_hi4(const u32x4 w) { return (f32x4){__uint_as_float(w.z << 16), __uint_as_float(w.z & 0xffff0000u), __uint_as_float(w.w << 16), __uint_as_float(w.w & 0xffff0000u)}; }
template <int SRC> struct EpiResidB {
    static constexpr bool PERM = true, AFTER_DRAIN = false;
    const float* xp; const float* xs; const bf16_t* RB; bf16_t* OB; float* SS; float alpha;
    __device__ __forceinline__ void operator()(const f32x4 (&acc)[2][2][4][2], const Unit& u, int wr, int wc, int fr, int fq) const {
        const int row0 = u.pm * BM + wr * 64 + fr, col0 = u.pn * BM + wc * 32 + 8 * fq;
        PG8_LAS float* red = (PG8_LAS float*)(unsigned)RED_LDS_OFF;
#pragma unroll
        for (int ai = 0; ai < 2; ++ai) {
            f32x4 rv[4][2][2]; u32x4 rb[4][2];
#pragma unroll
            for (int m = 0; m < 4; ++m) { const int row = row0 + ai * HALF + m * 16;
                if (SRC == 0) { const float* src = row < NPROMPT ? xp + (size_t)row * 1024 : xs + (size_t)(row - NPROMPT) * 1024;
#pragma unroll
                    for (int bj = 0; bj < 2; ++bj) { rv[m][bj][0] = __builtin_nontemporal_load((const f32x4*)(src + col0 + bj * HALF)); rv[m][bj][1] = __builtin_nontemporal_load((const f32x4*)(src + col0 + bj * HALF + 4)); } }
                else {
#pragma unroll
                    for (int bj = 0; bj < 2; ++bj) rb[m][bj] = __builtin_nontemporal_load((const u32x4*)(RB + (size_t)row * 1024 + col0 + bj * HALF)); } }
            __builtin_amdgcn_sched_barrier(0);
#pragma unroll
            for (int m = 0; m < 4; ++m) { const int row = row0 + ai * HALF + m * 16; float ssq = 0.f;
#pragma unroll
                for (int bj = 0; bj < 2; ++bj) { const int c = col0 + bj * HALF;
                    const f32x4 r0 = SRC == 0 ? rv[m][bj][0] : bf_lo4(rb[m][bj]), r1 = SRC == 0 ? rv[m][bj][1] : bf_hi4(rb[m][bj]);
                    const f32x4 x0 = r0 + acc[ai][bj][m][0] * alpha, x1 = r1 + acc[ai][bj][m][1] * alpha;
                    ssq += sumsq8(x0, x1);
                    *(u32x4*)(OB + (size_t)row * 1024 + c) = pack8(x0, x1); }
                ssq = fq_sum(ssq);
                if (fq == 0) red[(ai * HALF + wr * 64 + m * 16 + fr) * 4 + wc] = ssq; }
            __builtin_amdgcn_sched_barrier(0);
        }
        asm volatile("s_waitcnt lgkmcnt(0)" ::: "memory"); __builtin_amdgcn_s_barrier(); asm volatile("" ::: "memory");
        if (threadIdx.x < 256) { const f32x4 pv = *(const PG8_LAS f32x4*)(red + threadIdx.x * 4);
            SS[(size_t)(u.pm * BM + threadIdx.x) * 4 + u.pn] = (pv[0] + pv[1]) + (pv[2] + pv[3]); }
    }
};
struct EpiWin {
    static constexpr bool PERM = true, AFTER_DRAIN = false;
    const float* SSa; bf16_t* MIX; bf16_t* U; bf16_t* QL; bf16_t* KVL; bf16_t* KR; float* SSb; const float* qnorm; const float* kvnorm; const float* rope;
    __device__ __forceinline__ void operator()(const f32x4 (&acc)[2][2][4][2], const Unit& u, int wr, int wc, int fr, int fq) const {
        const int row0 = u.pm * BM + wr * 64 + fr, cw = wc * 32 + 8 * fq, pn = u.pn;
        float rsv[2][4];
        if (u.pm == NREAL / BM) rows_rstd(rsv, SSa + (size_t)MALLR * 4, 16, row0 - NREAL, 4, fq, 1.0f / 1024.0f);
        else rows_rstd4(rsv, SSa, row0, 1.0f / 1024.0f);
#pragma unroll
        for (int ai = 0; ai < 2; ++ai)
#pragma unroll
            for (int m = 0; m < 4; ++m) { const int row = row0 + ai * HALF + m * 16; const float rs = rsv[ai][m];
                f32x4 z[2][2];
#pragma unroll
                for (int bj = 0; bj < 2; ++bj) { z[bj][0] = acc[ai][bj][m][0] * rs; z[bj][1] = acc[ai][bj][m][1] * rs; }
                if (pn < 2) {
                    if (row < NREAL) {
#pragma unroll
                        for (int bj = 0; bj < 2; ++bj) __builtin_nontemporal_store(pack8(z[bj][0], z[bj][1]), (u32x4*)(MIX + (size_t)row * 1024 + pn * BM + bj * HALF + cw)); }
                } else if (pn < 6) {
                    __builtin_nontemporal_store(pack8(z[0][0] * z[1][0], z[0][1] * z[1][1]), (u32x4*)(U + (size_t)row * 512 + (pn - 2) * 128 + cw));
                } else {
#pragma unroll
                    for (int bj = 0; bj < 2; ++bj) { const int half = 2 * pn + bj;
                        if (half <= 14) { const int c = (half - 12) * 128 + cw; const float s = fq_sum(sumsq8(z[bj][0], z[bj][1]));
                            if (fq == 0) SSb[(size_t)row * 32 + (half - 12) * 4 + wc] = s;
                            const f32x4 g0 = *(const f32x4*)(qnorm + c), g1 = *(const f32x4*)(qnorm + c + 4);
                            __builtin_nontemporal_store(pack8(z[bj][0] * g0, z[bj][1] * g1), (u32x4*)(QL + (size_t)row * 384 + c));
                        } else if (half <= 16) { const int c = (half - 15) * 128 + cw; const float s = fq_sum(sumsq8(z[bj][0], z[bj][1]));
                            if (fq == 0) SSb[(size_t)row * 32 + 12 + (half - 15) * 4 + wc] = s;
                            const f32x4 g0 = *(const f32x4*)(kvnorm + c), g1 = *(const f32x4*)(kvnorm + c + 4);
                            __builtin_nontemporal_store(pack8(z[bj][0] * g0, z[bj][1] * g1), (u32x4*)(KVL + (size_t)row * 256 + c));
                        } else if (wc == 0) { f32x4 a = z[bj][0], b = z[bj][1]; rope8(a, b, rope, rope_pos(row), fq);
                            __builtin_nontemporal_store(pack8(a, b), (u32x4*)(KR + (size_t)row * 32 + 8 * fq)); } }
                } }
    }
};
struct EpiQup {
    static constexpr bool PERM = true, AFTER_DRAIN = false;
    const float* SSb; bf16_t* Q; const float* rope;
    __device__ __forceinline__ void operator()(const f32x4 (&acc)[2][2][4][2], const Unit& u, int wr, int wc, int fr, int fq) const {
        const int row0 = u.pm * BM + wr * 64 + fr;
        float rsv[2][4]; rows_rstd(rsv, SSb, 32, row0, 3, fq, 1.0f / 384.0f);
#pragma unroll
        for (int ai = 0; ai < 2; ++ai)
#pragma unroll
            for (int m = 0; m < 4; ++m) { const int row = row0 + ai * HALF + m * 16; const float rs = rsv[ai][m];
#pragma unroll
                for (int bj = 0; bj < 2; ++bj) { const int c32 = u.pn * 8 + bj * 4 + wc; f32x4 a = acc[ai][bj][m][0] * rs, b = acc[ai][bj][m][1] * rs;
                    if (c32 % 3 == 2) rope8(a, b, rope, rope_pos(row), fq);
                    __builtin_nontemporal_store(pack8(a, b), (u32x4*)(Q + (size_t)row * 768 + c32 * 32 + 8 * fq)); } }
    }
};
struct EpiKVup {
    static constexpr bool PERM = true, AFTER_DRAIN = false;
    const float* SSb; bf16_t* KV;
    __device__ __forceinline__ void operator()(const f32x4 (&acc)[2][2][4][2], const Unit& u, int wr, int wc, int fr, int fq) const {
        const int row0 = u.pm * BM + wr * 64 + fr, col0 = u.pn * BM + wc * 32 + 8 * fq;
        float rsv[2][4]; rows_rstd(rsv, SSb + 12, 32, row0, 2, fq, 1.0f / 256.0f);
#pragma unroll
        for (int ai = 0; ai < 2; ++ai)
#pragma unroll
            for (int m = 0; m < 4; ++m) { const int row = row0 + ai * HALF + m * 16; const float rs = rsv[ai][m];
#pragma unroll
                for (int bj = 0; bj < 2; ++bj) __builtin_nontemporal_store(pack8(acc[ai][bj][m][0] * rs, acc[ai][bj][m][1] * rs), (u32x4*)(KV + (size_t)row * 1024 + col0 + bj * HALF)); }
    }
};
template <class Epi, class Sched, bool ALIGN_EPI = false, bool SP2 = false>
__device__ __forceinline__ void gemm_phase(PG8_LAS unsigned char* lds, const Gemm g, const Sched& S, const Epi& E) {
    const int tid = threadIdx.x, wid = __builtin_amdgcn_readfirstlane(tid >> 6), lane = tid & 63, wr = wid >> 2, wc = wid & 3, fr = lane & 15, fq = lane >> 4;
    const int K = g.K, nt = K / BK;
    unsigned voffA[2], voffB[2];
#pragma unroll
    for (int i = 0; i < 2; ++i) { int R, C; stage_rc(tid * 16 + i * 8192, R, C); const int Rb = Epi::PERM ? ((R & ~31) + perm32(R & 31)) : R;
        voffA[i] = (unsigned)(R * K + C) * 2u; voffB[i] = (unsigned)(Rb * K + C) * 2u; }
    const size_t kstep = (size_t)(BK * 2);
    const size_t hstep = (size_t)HALF * K * 2;
    const size_t tstep = 2 * hstep;
    const unsigned ldsw = (unsigned)wid * 1024u;
    const int aoff = lds_byte(wr * 64 + fr, fq * 8), boff = lds_byte(wc * 32 + fr, fq * 8);
#define PG8_SA(b, h) (((b) * 2 + (h)) * HTB)
#define PG8_SB(b, h) ((4 + (b) * 2 + (h)) * HTB)
#define PG8_STAGE(bufoff, gbase, voff) do { _Pragma("unroll") for (int _i = 0; _i < 2; ++_i) \
        __builtin_amdgcn_global_load_lds((const unsigned*)((const char*)(gbase) + (voff)[_i]), (PG8_LAS unsigned*)(lds + (bufoff) + ldsw + _i * 8192), 16, 0, 0); } while (0)
#define PG8_LDA(dst, b, h) do { _Pragma("unroll") for (int m = 0; m < 4; ++m) _Pragma("unroll") for (int k = 0; k < 2; ++k) dst[m][k] = *(const PG8_LAS bf16x8*)(lds + PG8_SA(b, h) + aoff + m * 2048 + k * 1024); } while (0)
#define PG8_LDB(dst, b, h) do { _Pragma("unroll") for (int n = 0; n < 2; ++n) _Pragma("unroll") for (int k = 0; k < 2; ++k) dst[n][k] = *(const PG8_LAS bf16x8*)(lds + PG8_SB(b, h) + boff + n * 2048 + k * 1024); } while (0)
#define PG8_MMA(ai, bj, At, Bt) do { __builtin_amdgcn_s_setprio(1); _Pragma("unroll") for (int m = 0; m < 4; ++m) _Pragma("unroll") for (int n = 0; n < 2; ++n) _Pragma("unroll") for (int k = 0; k < 2; ++k) \
        acc[ai][bj][m][n] = __builtin_amdgcn_mfma_f32_16x16x32_bf16(Bt[n][k], At[m][k], acc[ai][bj][m][n], 0, 0, 0); __builtin_amdgcn_s_setprio(0); } while (0)
#define PG8_WAIT_V(n) asm volatile("s_waitcnt vmcnt(" #n ")" ::: "memory")
#define PG8_WAIT_L(n) asm volatile("s_waitcnt lgkmcnt(" #n ")" ::: "memory")
#define PG8_BAR __builtin_amdgcn_s_barrier()
#define PG8_SCHED __builtin_amdgcn_sched_barrier(0)
    Unit cur, nxt; int ui = 0;
    if (!S.next(0, cur)) return;
    f32x4 acc[2][2][4][2];
#pragma unroll
    for (int a = 0; a < 2; ++a)
#pragma unroll
        for (int b = 0; b < 2; ++b)
#pragma unroll
            for (int m = 0; m < 4; ++m)
#pragma unroll
                for (int n = 0; n < 2; ++n) acc[a][b][m][n] = (f32x4){0.f, 0.f, 0.f, 0.f};
    bf16x8 At[4][2], B0[2][2], B1[2][2];
    const char* cA = (const char*)g.A + (size_t)cur.pm * tstep; const char* cB = (const char*)g.Bt + (size_t)cur.pn * tstep;
    S.a_ready(cur);
    if constexpr (SP2) {
        PG8_STAGE(PG8_SB(0, 0), cB, voffB); PG8_STAGE(PG8_SB(0, 1), cB + hstep, voffB); PG8_STAGE(PG8_SA(0, 0), cA, voffA); PG8_STAGE(PG8_SA(0, 1), cA + hstep, voffA);
        if (wr == 1) PG8_BAR;
        PG8_WAIT_V(2); PG8_BAR;
        PG8_STAGE(PG8_SB(1, 0), cB + kstep, voffB); PG8_STAGE(PG8_SA(1, 0), cA + kstep, voffA); PG8_STAGE(PG8_SB(1, 1), cB + hstep + kstep, voffB);
        PG8_WAIT_V(6); PG8_BAR;
    } else {
        PG8_STAGE(PG8_SB(0, 0), cB, voffB); PG8_STAGE(PG8_SA(0, 0), cA, voffA); PG8_STAGE(PG8_SB(0, 1), cB + hstep, voffB); PG8_STAGE(PG8_SA(0, 1), cA + hstep, voffA);
        if (wr == 1) PG8_BAR;
        PG8_WAIT_V(4); PG8_BAR;
        PG8_STAGE(PG8_SB(1, 0), cB + kstep, voffB); PG8_STAGE(PG8_SA(1, 0), cA + kstep, voffA); PG8_STAGE(PG8_SB(1, 1), cB + hstep + kstep, voffB);
        PG8_WAIT_V(6); PG8_BAR;
    }
    for (;;) {
        const bool has_next = S.next(ui + 1, nxt);
        const char* nA = has_next ? (const char*)g.A + (size_t)nxt.pm * tstep : cA; const char* nB = has_next ? (const char*)g.Bt + (size_t)nxt.pn * tstep : cB;
        for (int t = 0; t < nt; t += 2) {
            const bool last = (t == nt - 2);
            const char* a1 = cA + (size_t)(t + 1) * kstep;
            const char* a2 = last ? nA : cA + (size_t)(t + 2) * kstep; const char* b2 = last ? nB : cB + (size_t)(t + 2) * kstep;
            const char* a3 = a2 + kstep; const char* b3 = b2 + kstep;
            if (last && has_next) S.a_ready(nxt);
            if constexpr (SP2) {
            PG8_LDB(B0, 0, 0); PG8_LDB(B1, 0, 1); PG8_SCHED; PG8_LDA(At, 0, 0); PG8_STAGE(PG8_SA(1, 1), a1 + hstep, voffA);
            PG8_WAIT_V(8); PG8_WAIT_L(0); PG8_BAR; PG8_MMA(0, 0, At, B0); PG8_MMA(0, 1, At, B1); PG8_BAR; PG8_SCHED;
            PG8_LDA(At, 0, 1); PG8_STAGE(PG8_SB(0, 0), b2, voffB); PG8_STAGE(PG8_SB(0, 1), b2 + hstep, voffB); PG8_STAGE(PG8_SA(0, 0), a2, voffA);
            PG8_WAIT_V(8); PG8_WAIT_L(0); PG8_BAR; PG8_MMA(1, 0, At, B0); PG8_MMA(1, 1, At, B1); PG8_BAR; PG8_SCHED;
            PG8_LDB(B0, 1, 0); PG8_LDB(B1, 1, 1); PG8_SCHED; PG8_LDA(At, 1, 0); PG8_STAGE(PG8_SA(0, 1), a2 + hstep, voffA);
            PG8_WAIT_V(8); PG8_WAIT_L(0); PG8_BAR; PG8_MMA(0, 0, At, B0); PG8_MMA(0, 1, At, B1); PG8_BAR; PG8_SCHED;
            PG8_LDA(At, 1, 1); PG8_STAGE(PG8_SB(1, 0), b3, voffB); PG8_STAGE(PG8_SB(1, 1), b3 + hstep, voffB); PG8_STAGE(PG8_SA(1, 0), a3, voffA);
            PG8_WAIT_V(8); PG8_WAIT_L(0); PG8_BAR; PG8_MMA(1, 0, At, B0); PG8_MMA(1, 1, At, B1); PG8_BAR; PG8_SCHED;
            } else {
            PG8_LDB(B0, 0, 0); PG8_SCHED; PG8_LDA(At, 0, 0); PG8_STAGE(PG8_SA(1, 1), a1 + hstep, voffA);
            PG8_WAIT_L(8); PG8_BAR; PG8_WAIT_L(0); PG8_MMA(0, 0, At, B0); PG8_BAR; PG8_SCHED;
            PG8_LDB(B1, 0, 1); PG8_STAGE(PG8_SB(0, 0), b2, voffB);
            PG8_BAR; PG8_WAIT_L(0); PG8_MMA(0, 1, At, B1); PG8_BAR;
            PG8_LDA(At, 0, 1); PG8_STAGE(PG8_SA(0, 0), a2, voffA);
            PG8_BAR; PG8_WAIT_L(0); PG8_MMA(1, 0, At, B0); PG8_BAR; PG8_SCHED;
            PG8_STAGE(PG8_SB(0, 1), b2 + hstep, voffB);
            PG8_WAIT_V(6); PG8_BAR; PG8_MMA(1, 1, At, B1); PG8_BAR;
            PG8_LDB(B0, 1, 0); PG8_SCHED; PG8_LDA(At, 1, 0); PG8_STAGE(PG8_SA(0, 1), a2 + hstep, voffA);
            PG8_WAIT_L(8); PG8_BAR; PG8_WAIT_L(0); PG8_MMA(0, 0, At, B0); PG8_BAR; PG8_SCHED;
            PG8_LDB(B1, 1, 1); PG8_STAGE(PG8_SB(1, 0), b3, voffB);
            PG8_BAR; PG8_WAIT_L(0); PG8_MMA(0, 1, At, B1); PG8_BAR;
            PG8_LDA(At, 1, 1); PG8_STAGE(PG8_SA(1, 0), a3, voffA);
            PG8_BAR; PG8_WAIT_L(0); PG8_MMA(1, 0, At, B0); PG8_BAR; PG8_SCHED;
            PG8_STAGE(PG8_SB(1, 1), b3 + hstep, voffB);
            PG8_WAIT_V(6); PG8_BAR; PG8_MMA(1, 1, At, B1); PG8_BAR;
            }
        }
        if constexpr (ALIGN_EPI) { if (wr == 0) PG8_BAR; }
        if constexpr (!Epi::AFTER_DRAIN) { E(acc, cur, wr, wc, fr, fq); S.done(cur); }
        if (!has_next) break;
#pragma unroll
        for (int a = 0; a < 2; ++a)
#pragma unroll
            for (int b = 0; b < 2; ++b)
#pragma unroll
                for (int m = 0; m < 4; ++m)
#pragma unroll
                    for (int n = 0; n < 2; ++n) acc[a][b][m][n] = (f32x4){0.f, 0.f, 0.f, 0.f};
        cur = nxt; cA = nA; cB = nB; ++ui;
        if constexpr (ALIGN_EPI) { if (wr == 1) PG8_BAR; }
    }
    PG8_WAIT_V(0);
    if constexpr (!ALIGN_EPI) { if (wr == 0) PG8_BAR; }
    PG8_BAR;
    if constexpr (Epi::AFTER_DRAIN) { E.fused(acc, cur, wr, wc, fr, fq, lds, wid, lane); S.done(cur); }
#undef PG8_SA
#undef PG8_SB
#undef PG8_STAGE
#undef PG8_LDA
#undef PG8_LDB
#undef PG8_MMA
#undef PG8_WAIT_V
#undef PG8_WAIT_L
#undef PG8_BAR
#undef PG8_SCHED
}
}
namespace att {
using bf16x8 = __attribute__((ext_vector_type(8))) short;
using s16x4  = __attribute__((ext_vector_type(4))) short;
using f32x16 = __attribute__((ext_vector_type(16))) float;
using u32x4  = __attribute__((ext_vector_type(4))) unsigned;
typedef unsigned short bf16_t;
constexpr int NW = 8, QBLK = 32, KVBLK = 64;
constexpr float SCALE = 0.10206207261596577f;
constexpr float THR = 8.f;
constexpr int SHM_V = 16384, SHM_K = 16384, SHM_ATTN = 3 * (SHM_V + SHM_K) + NW * 64 * 4;
constexpr int LDQ = 768, LDKV = 1024, LDKR = 32, LDO = 1024, META_ROW0 = 49152;
#define KSWZ(row, colB) ((row) * 256 + ((colB) ^ (((row) & 15) << 4)))
#define SBAR() __builtin_amdgcn_sched_barrier(0)
__device__ __forceinline__ int crow(int r, int hi) { return (r & 3) + 8 * (r >> 2) + 4 * hi; }
__device__ __forceinline__ unsigned cvtpk(float lo, float hi) { unsigned r; asm volatile("v_cvt_pk_bf16_f32 %0, %1, %2" : "=v"(r) : "v"(lo), "v"(hi)); return r; }
__device__ __forceinline__ bf16x8 ld8(const bf16_t* p) { return *reinterpret_cast<const bf16x8*>(p); }

__device__ __forceinline__ void partialSM(f32x16& p0, f32x16& p1, float& m_reg, float& mn, float& alpha) {
  constexpr float C = SCALE * 1.4426950408889634f;
  float pmax = p0[0];
#pragma unroll
  for (int r = 1; r < 16; ++r) pmax = fmaxf(pmax, p0[r]);
#pragma unroll
  for (int r = 0; r < 16; ++r) pmax = fmaxf(pmax, p1[r]);
  { auto rr = __builtin_amdgcn_permlane32_swap(__float_as_uint(pmax), __float_as_uint(pmax), false, false);
    pmax = fmaxf(__uint_as_float(rr[0]), __uint_as_float(rr[1])); }
  if (__builtin_expect(__all(pmax - m_reg <= THR / SCALE), 1)) { mn = m_reg; alpha = 1.f; }
  else { mn = fmaxf(m_reg, pmax); alpha = __builtin_amdgcn_exp2f((m_reg - mn) * C); m_reg = mn; }
  float mnC = -mn * C;
#pragma unroll
  for (int r = 0; r < 16; ++r) p0[r] = fmaf(p0[r], C, mnC);
#pragma unroll
  for (int r = 0; r < 16; ++r) p1[r] = fmaf(p1[r], C, mnC);
#pragma unroll
  for (int r = 0; r < 16; ++r) p0[r] = __builtin_amdgcn_exp2f(p0[r]);
}
__device__ __forceinline__ void finishSM(f32x16& p0, f32x16& p1, float alpha, float& l_reg, bf16x8& pa0, bf16x8& pa1, bf16x8& pa2, bf16x8& pa3) {
#pragma unroll
  for (int r = 0; r < 16; ++r) p1[r] = __builtin_amdgcn_exp2f(p1[r]);
  float ps = 0;
#pragma unroll
  for (int r = 0; r < 16; ++r) ps += p0[r];
#pragma unroll
  for (int r = 0; r < 16; ++r) ps += p1[r];
  { auto rr = __builtin_amdgcn_permlane32_swap(__float_as_uint(ps), __float_as_uint(ps), false, false);
    ps = __uint_as_float(rr[0]) + __uint_as_float(rr[1]); }
  l_reg = l_reg * alpha + ps;
#define PK4(P, BASE, OUT) do { unsigned a0 = cvtpk(P[BASE + 0], P[BASE + 1]), a1 = cvtpk(P[BASE + 2], P[BASE + 3]);   \
    unsigned b0 = cvtpk(P[BASE + 4], P[BASE + 5]), b1 = cvtpk(P[BASE + 6], P[BASE + 7]);                              \
    auto r0 = __builtin_amdgcn_permlane32_swap(a0, b0, false, false); auto r1 = __builtin_amdgcn_permlane32_swap(a1, b1, false, false); \
    u32x4 w = {r0[0], r1[0], r0[1], r1[1]}; OUT = *reinterpret_cast<bf16x8*>(&w); } while (0)
  PK4(p0, 0, pa0); PK4(p0, 8, pa1); PK4(p1, 0, pa2); PK4(p1, 8, pa3);
#undef PK4
}
__device__ __forceinline__ void qkt(f32x16& p0, f32x16& p1, const char* Ks, const bf16x8* qr, int r32, int hi) {
  p0 = f32x16{}; p1 = f32x16{};
#pragma unroll
  for (int d0 = 0; d0 < 6; ++d0) { const int cb = (d0 * 16 + hi * 8) * 2;
    bf16x8 b0 = *reinterpret_cast<const bf16x8*>(Ks + KSWZ(r32, cb));
    bf16x8 b1 = *reinterpret_cast<const bf16x8*>(Ks + KSWZ(32 + r32, cb));
    p0 = __builtin_amdgcn_mfma_f32_32x32x16_bf16(b0, qr[d0], p0, 0, 0, 0);
    p1 = __builtin_amdgcn_mfma_f32_32x32x16_bf16(b1, qr[d0], p1, 0, 0, 0); }
}
__device__ __forceinline__ int v_st(int k, int c) { const int kk = (k & ~0xC) | ((k & 4) << 1) | ((k & 8) >> 1); return ((kk >> 3) * 4 + (c >> 5)) * 512 + ((kk & 7) * 32 + (c & 31)) * 2; }
__device__ __forceinline__ int v_rd_base(int lane) { return ((lane & 3) << 3) | (((lane >> 2) & 3) << 6) | (((lane >> 4) & 1) << 5) | (((lane >> 5) & 1) << 8); }
constexpr int v_rd_off(int d0, int ks, int half) { return d0 * 512 + ks * 4096 + half * 2048; }
template <int OFF> __device__ __forceinline__ s16x4 tr_read(int vb) {
  s16x4 r; asm volatile("ds_read_b64_tr_b16 %0, %1 offset:%2" : "=&v"(r) : "v"(vb), "i"(OFF) : "memory"); return r;
}
template <int D0> __device__ __forceinline__ void pv_one(f32x16& od, int vb, bf16x8 pa0, bf16x8 pa1, bf16x8 pa2, bf16x8 pa3) {
  const s16x4 l0 = tr_read<v_rd_off(D0, 0, 0)>(vb), h0 = tr_read<v_rd_off(D0, 0, 1)>(vb), l1 = tr_read<v_rd_off(D0, 1, 0)>(vb), h1 = tr_read<v_rd_off(D0, 1, 1)>(vb);
  const s16x4 l2 = tr_read<v_rd_off(D0, 2, 0)>(vb), h2 = tr_read<v_rd_off(D0, 2, 1)>(vb), l3 = tr_read<v_rd_off(D0, 3, 0)>(vb), h3 = tr_read<v_rd_off(D0, 3, 1)>(vb);
  asm volatile("s_waitcnt lgkmcnt(0)" ::: "memory"); SBAR();
#define PK(L, H) (bf16x8){L[0], L[1], L[2], L[3], H[0], H[1], H[2], H[3]}
  od = __builtin_amdgcn_mfma_f32_32x32x16_bf16(pa0, PK(l0, h0), od, 0, 0, 0);
  od = __builtin_amdgcn_mfma_f32_32x32x16_bf16(pa1, PK(l1, h1), od, 0, 0, 0);
  od = __builtin_amdgcn_mfma_f32_32x32x16_bf16(pa2, PK(l2, h2), od, 0, 0, 0);
  od = __builtin_amdgcn_mfma_f32_32x32x16_bf16(pa3, PK(l3, h3), od, 0, 0, 0);
#undef PK
}
__device__ __forceinline__ void pv_d0(f32x16* o, int vb, bf16x8 pa0, bf16x8 pa1, bf16x8 pa2, bf16x8 pa3) {
  const s16x4 l0 = tr_read<v_rd_off(0, 0, 0)>(vb), h0 = tr_read<v_rd_off(0, 0, 1)>(vb), l1 = tr_read<v_rd_off(0, 1, 0)>(vb), h1 = tr_read<v_rd_off(0, 1, 1)>(vb);
  const s16x4 l2 = tr_read<v_rd_off(0, 2, 0)>(vb), h2 = tr_read<v_rd_off(0, 2, 1)>(vb), l3 = tr_read<v_rd_off(0, 3, 0)>(vb), h3 = tr_read<v_rd_off(0, 3, 1)>(vb);
  const s16x4 m0 = tr_read<v_rd_off(1, 0, 0)>(vb), g0 = tr_read<v_rd_off(1, 0, 1)>(vb), m1 = tr_read<v_rd_off(1, 1, 0)>(vb), g1 = tr_read<v_rd_off(1, 1, 1)>(vb);
  const s16x4 m2 = tr_read<v_rd_off(1, 2, 0)>(vb), g2 = tr_read<v_rd_off(1, 2, 1)>(vb), m3 = tr_read<v_rd_off(1, 3, 0)>(vb), g3 = tr_read<v_rd_off(1, 3, 1)>(vb);
  asm volatile("s_waitcnt lgkmcnt(8)" ::: "memory"); SBAR();
#define PK(L, H) (bf16x8){L[0], L[1], L[2], L[3], H[0], H[1], H[2], H[3]}
  o[0] = __builtin_amdgcn_mfma_f32_32x32x16_bf16(pa0, PK(l0, h0), o[0], 0, 0, 0);
  o[0] = __builtin_amdgcn_mfma_f32_32x32x16_bf16(pa1, PK(l1, h1), o[0], 0, 0, 0);
  o[0] = __builtin_amdgcn_mfma_f32_32x32x16_bf16(pa2, PK(l2, h2), o[0], 0, 0, 0);
  o[0] = __builtin_amdgcn_mfma_f32_32x32x16_bf16(pa3, PK(l3, h3), o[0], 0, 0, 0);
  SBAR(); asm volatile("s_waitcnt lgkmcnt(0)" ::: "memory"); SBAR();
  o[1] = __builtin_amdgcn_mfma_f32_32x32x16_bf16(pa0, PK(m0, g0), o[1], 0, 0, 0);
  o[1] = __builtin_amdgcn_mfma_f32_32x32x16_bf16(pa1, PK(m1, g1), o[1], 0, 0, 0);
  o[1] = __builtin_amdgcn_mfma_f32_32x32x16_bf16(pa2, PK(m2, g2), o[1], 0, 0, 0);
  o[1] = __builtin_amdgcn_mfma_f32_32x32x16_bf16(pa3, PK(m3, g3), o[1], 0, 0, 0);
#undef PK
}

__device__ __forceinline__ void attn_unit(const bf16_t* __restrict__ Q, const bf16_t* __restrict__ KV, const bf16_t* __restrict__ KR, bf16_t* __restrict__ O,
                                          int qrow0, int kvrow0, int NT, int h, char* lds) {
  const int tid = threadIdx.x, wid = __builtin_amdgcn_readfirstlane(tid >> 6), lane = tid & 63, r32 = lane & 31, hi = lane >> 5;
  const bool grpA = wid < 4;
  constexpr int SLOT = SHM_K + SHM_V;
  char* ring = lds;
  float* ws = (float*)(lds + 3 * SLOT) + wid * 64; float* li_l = ws; float* al_l = ws + 32;
  float m_reg = -1e30f, l_reg = 0; f32x16 o[2] = {}; bf16x8 qr[6];
  const bf16_t* Qw = Q + (size_t)(qrow0 + wid * QBLK + r32) * LDQ + h * 96 + hi * 8;
#pragma unroll
  for (int d0 = 0; d0 < 6; ++d0) qr[d0] = ld8(Qw + d0 * 16);
  const int sr = tid >> 3, sc = tid & 7;
  const int vst = SHM_K + v_st(sr, sc * 8), kst = KSWZ(sr, sc * 16), krst = KSWZ(sr, 128 + sc * 16);
  const int vb0 = (int)(uintptr_t)ring + SHM_K + v_rd_base(lane);
  const bf16_t* kvp = KV + (size_t)sr * LDKV + h * 128 + sc * 8; const bf16_t* krp = KR + (size_t)sr * LDKR + (sc & 3) * 8;
  bf16x8 kn0, vv0, kr0, kn1, vv1, kr1;
#define TROW(t) ((t) == 0 ? META_ROW0 : kvrow0 + ((t) - 1) * KVBLK)
#define TCL(t) ((t) < NT ? (t) : NT - 1)
#define SLOAD0(t) do { const size_t rb_ = (size_t)TROW(t); kn0 = ld8(kvp + rb_ * LDKV); vv0 = ld8(kvp + rb_ * LDKV + 64); kr0 = ld8(krp + rb_ * LDKR); } while (0)
#define SLOAD1(t) do { const size_t rb_ = (size_t)TROW(t); kn1 = ld8(kvp + rb_ * LDKV); vv1 = ld8(kvp + rb_ * LDKV + 64); kr1 = ld8(krp + rb_ * LDKR); } while (0)
#define SWRITE0(off) do { *(bf16x8*)(ring + (off) + vst) = vv0; *(bf16x8*)(ring + (off) + kst) = kn0; if (sc < 4) *(bf16x8*)(ring + (off) + krst) = kr0; } while (0)
#define SWRITE1(off) do { *(bf16x8*)(ring + (off) + vst) = vv1; *(bf16x8*)(ring + (off) + kst) = kn1; if (sc < 4) *(bf16x8*)(ring + (off) + krst) = kr1; } while (0)
#define SWAIT() asm volatile("s_waitcnt vmcnt(3)" ::: "memory")
#define RESC(a) do { if (__any((a) < 1.f)) { if (hi == 0) al_l[r32] = (a); asm volatile("s_waitcnt lgkmcnt(0)" ::: "memory"); \
    _Pragma("unroll") for (int d = 0; d < 2; ++d) _Pragma("unroll") for (int r = 0; r < 16; ++r) o[d][r] *= al_l[crow(r, hi)]; } } while (0)
  f32x16 p0, p1; float mn, al; bf16x8 pa0, pa1, pa2, pa3;
  p0 = f32x16{}; p1 = f32x16{}; pa0 = bf16x8{}; pa1 = pa0; pa2 = pa0; pa3 = pa0;
#define PVSEG(bp) pv_d0(o, vb0 + (bp), pa0, pa1, pa2, pa3)
#define QKSEG(bc) qkt(p0, p1, ring + (bc), qr, r32, hi)
#define SSEG() do { partialSM(p0, p1, m_reg, mn, al); RESC(al); finishSM(p0, p1, al, l_reg, pa0, pa1, pa2, pa3); } while (0)
  SLOAD0(0); asm volatile("s_waitcnt vmcnt(0)" ::: "memory"); SWRITE0(0);
  SLOAD1(1); SLOAD0(2);
  __syncthreads();
  if (!grpA) __syncthreads();
  int bprev = 0, bcur = SLOT, bnext = 2 * SLOT;
  SWAIT(); SWRITE1(SLOT); SLOAD1(TCL(3)); SBAR();
  QKSEG(0);
  __syncthreads();
#pragma unroll
  for (int r = 8; r < 16; ++r) p0[r] = -INFINITY;
#pragma unroll
  for (int r = 0; r < 16; ++r) p1[r] = -INFINITY;
  SSEG();
  __syncthreads();
#define ROT() do { const int t_ = bprev; bprev = bcur; bcur = bnext; bnext = t_; } while (0)
  for (int t = 1; t < NT; t += 2) {
    SWAIT(); SWRITE0(bnext); SLOAD0(TCL(t + 3)); SBAR();
    PVSEG(bprev); QKSEG(bcur);
    __syncthreads();
    SSEG();
    __syncthreads();
    ROT();
    SWAIT(); SWRITE1(bnext); SLOAD1(TCL(t + 4)); SBAR();
    PVSEG(bprev); QKSEG(bcur);
    __syncthreads();
    SSEG();
    __syncthreads();
    ROT();
  }
  PVSEG(bprev);
  __syncthreads();
  __syncthreads();
  if (grpA) __syncthreads();
  if (hi == 0) li_l[r32] = l_reg; asm volatile("s_waitcnt lgkmcnt(0)" ::: "memory");
  float rli[16];
#pragma unroll
  for (int r = 0; r < 16; ++r) rli[r] = __builtin_amdgcn_rcpf(li_l[crow(r, hi)]);
  bf16_t* Ow = O + (size_t)(qrow0 + wid * QBLK) * LDO + 512 + h * 64;
#pragma unroll
  for (int r = 0; r < 16; ++r) { const int orow = crow(r, hi);
#pragma unroll
    for (int d0 = 0; d0 < 2; ++d0) { const unsigned w = cvtpk(o[d0][r] * rli[r], 0.f); Ow[(size_t)orow * LDO + d0 * 32 + r32] = (bf16_t)(w & 0xffffu); } }
  asm volatile("s_waitcnt vmcnt(0)" ::: "memory");
  __syncthreads();
#undef TROW
#undef TCL
#undef SLOAD0
#undef SLOAD1
#undef SWRITE0
#undef SWRITE1
#undef SWAIT
#undef RESC
#undef PVSEG
#undef QKSEG
#undef SSEG
#undef ROT
}
__device__ __forceinline__ void attn_phase(const bf16_t* Q, const bf16_t* KV, const bf16_t* KR, bf16_t* O, int vcu, int G, char* lds) {
  for (int u = vcu; u < 1536; u += G) {
    int qrow0, kvrow0, NT, h;
    if (u < 512) { const int sh = u >> 4, qb = u & 15, seq = sh >> 3; h = sh & 7; kvrow0 = seq * 4096; qrow0 = kvrow0 + qb * 256; NT = 65; }
    else { const int v = u - 512, sh = v >> 3, qb = v & 7, seq = sh >> 3; h = sh & 7; kvrow0 = 16384 + seq * 2048; qrow0 = kvrow0 + qb * 256; NT = 33; }
    attn_unit(Q, KV, KR, O, qrow0, kvrow0, NT, h, lds);
  }
}
#undef KSWZ
#undef SBAR
}
#ifndef MK_N_LAUNCHES
#define MK_N_LAUNCHES 1
#endif
constexpr int N_LAUNCHES = MK_N_LAUNCHES;
constexpr int N_PHASES = 10;
#define LAS __attribute__((address_space(3)))
typedef unsigned short bf16;
typedef unsigned v4u __attribute__((ext_vector_type(4)));
typedef float f32x4 __attribute__((ext_vector_type(4)));
constexpr int DM = 1024, DFF = 2816, NREAL = 49152, MALLR = 49408, NPROMPT = 16384, NGU = 2 * DFF, NINP = 2304, DIN = 2208;
constexpr int NWAVES = 8;
constexpr size_t SZ_WGU = (size_t)NGU * DM * 2, SZ_WD = (size_t)DM * DFF * 2;
constexpr size_t WS_WGU1 = 0, WS_WD1 = WS_WGU1 + SZ_WGU, WS_WGU2 = WS_WD1 + SZ_WD, WS_WD2 = WS_WGU2 + SZ_WGU;
constexpr size_t WS_WIN = WS_WD2 + SZ_WD, WS_WUQ = WS_WIN + (size_t)NINP * DM * 2, WS_WUKV = WS_WUQ + (size_t)768 * 384 * 2, WS_WOUT = WS_WUKV + (size_t)1024 * 256 * 2;
constexpr size_t WS_XN = WS_WOUT + (size_t)DM * DM * 2;
constexpr size_t WS_H = WS_XN + (size_t)MALLR * DM * 2;
constexpr size_t SZ_H = (size_t)MALLR * DFF * 2;
constexpr size_t WS_U = WS_H, WS_QL = WS_U + (size_t)MALLR * 512 * 2, WS_KVL = WS_QL + (size_t)MALLR * 384 * 2, WS_KR = WS_KVL + (size_t)MALLR * 256 * 2, WS_Q = WS_KR + (size_t)MALLR * 32 * 2;
static_assert(WS_Q + (size_t)NREAL * 768 * 2 <= WS_H + SZ_H, "overlay fits in h");
constexpr size_t WS_MIX = WS_H + SZ_H;
constexpr size_t WS_SSA = WS_MIX + (size_t)NREAL * DM * 2;
constexpr size_t WS_SSB = WS_SSA + (size_t)MALLR * 16 * 4;
constexpr size_t WS_ROPE = WS_SSB + (size_t)MALLR * 32 * 4;
constexpr size_t WS_CTL = WS_ROPE + (size_t)4112 * 16 * 8, CTL_BYTES = 65536;
constexpr size_t WS_END = WS_CTL + CTL_BYTES;
static_assert(WS_END <= 536870912ull, "d_ws map exceeds 512 MiB");
static_assert(WS_CTL % 256 == 0 && WS_WD1 % 256 == 0 && WS_WIN % 256 == 0 && WS_XN % 256 == 0 && WS_H % 256 == 0 && WS_MIX % 256 == 0 && WS_SSA % 256 == 0 && WS_ROPE % 256 == 0 && WS_Q % 256 == 0 && WS_KR % 256 == 0, "alignment");
constexpr int LDS_BYTES = 139264;
constexpr int MISC_OFF = pg8::STAGE_BYTES;
static_assert(att::SHM_ATTN <= pg8::STAGE_BYTES && MISC_OFF + 256 <= LDS_BYTES, "LDS");

#define LDS_WAIT() asm volatile("s_waitcnt lgkmcnt(0)" ::: "memory")
__device__ __forceinline__ unsigned f2bf(float f) { unsigned u = __builtin_bit_cast(unsigned, f); return (u + 0x7fffu + ((u >> 16) & 1u)) >> 16; }
__device__ __forceinline__ unsigned pk2(float lo, float hi) { return f2bf(lo) | (f2bf(hi) << 16); }
__device__ __forceinline__ float bflo(unsigned w) { return __builtin_bit_cast(float, w << 16); }
__device__ __forceinline__ float bfhi(unsigned w) { return __builtin_bit_cast(float, w & 0xffff0000u); }
__device__ __forceinline__ float wave_sum(float v) {
#pragma unroll
    for (int o = 1; o < 64; o <<= 1) v += __shfl_xor(v, o);
    return v;
}
__device__ __forceinline__ void p0_transpose_item(const float* W, int K, int N, bf16* WT, int k0, int n0, int drow0, LAS float* scr, int lane, const float* gk = nullptr) {
#pragma unroll 8
    for (int i = 0; i < 32; ++i) { const int kk = 2 * i + (lane >> 5); const float gsc = gk ? gk[k0 + kk] : 1.0f; scr[kk * 33 + (lane & 31)] = W[(size_t)(k0 + kk) * N + n0 + (lane & 31)] * gsc; }
    LDS_WAIT(); asm volatile("" ::: "memory");
    const int c = lane & 7;
#pragma unroll
    for (int j = 0; j < 4; ++j) { const int n = (lane >> 3) + 8 * j; const LAS float* s = scr + (8 * c) * 33 + n;
        v4u o; o.x = pk2(s[0 * 33], s[1 * 33]); o.y = pk2(s[2 * 33], s[3 * 33]); o.z = pk2(s[4 * 33], s[5 * 33]); o.w = pk2(s[6 * 33], s[7 * 33]);
        *(v4u*)(WT + (size_t)(drow0 + n) * K + k0 + 8 * c) = o; }
    LDS_WAIT(); asm volatile("" ::: "memory");
}
__device__ __forceinline__ int map_gu(int n0, int up) { return (n0 >> 7) * 256 + up * 128 + (n0 & 127); }
__device__ __forceinline__ int map_win(int n0) {
    if (n0 < 512) return n0;
    if (n0 < 1024) { const int t = n0 - 512; return 512 + (t >> 7) * 256 + (t & 127); }
    if (n0 < 1536) { const int t = n0 - 1024; return 512 + (t >> 7) * 256 + 128 + (t & 127); }
    return n0;
}

typedef __attribute__((address_space(1))) unsigned gu32;
#define RLX_AGENT __ATOMIC_RELAXED, __HIP_MEMORY_SCOPE_AGENT
#define XB_TMO      128
#define XB_XCNT(j)  (256  + 64 * (j))
#define XB_XSUB(j)  (1280 + 64 * (j))
#define XB_XGEN(j)  (2304 + 64 * (j))
#define XB_TOP      3328
#define XB_TOPGEN   3392
#define XCD_BAR_WORDS 3456
#define XB_SPIN_CAP (1u << 18)

__device__ __forceinline__ unsigned xb_ld(unsigned* p)              { return __hip_atomic_load(p, __ATOMIC_RELAXED, __HIP_MEMORY_SCOPE_AGENT); }
__device__ __forceinline__ unsigned xb_add(unsigned* p, unsigned v) { return __hip_atomic_fetch_add(p, v, __ATOMIC_RELAXED, __HIP_MEMORY_SCOPE_AGENT); }
__device__ __forceinline__ unsigned xb_xcc_id() { return (unsigned)__builtin_amdgcn_s_getreg((3 << 11) | 20) & 0xFu; }
#define XB_SPIN(cond, bar) do { unsigned _sp = 0; while (cond) { __builtin_amdgcn_s_sleep(1); \
    if ((++_sp & 255u) == 0u) { if (xb_ld(&(bar)[XB_TMO])) break; if (_sp > XB_SPIN_CAP) { atomicAdd(&(bar)[XB_TMO], 1u); break; } } } } while (0)

struct XcdBarrier {
    unsigned* bar; unsigned x;
    volatile LAS unsigned* st;
};

__device__ __forceinline__ XcdBarrier xcd_barrier_post(unsigned* bar, volatile LAS unsigned* st) {
    XcdBarrier b; b.bar = bar; b.x = xb_xcc_id(); b.st = st;
    if (threadIdx.x == 0) (void)xb_add(&bar[XB_XCNT(b.x)], 1u);
    return b;
}
__device__ __forceinline__ void xcd_barrier_complete(unsigned* bar, unsigned x, unsigned& nloc, unsigned& nx) {
    const unsigned G = gridDim.x * gridDim.y * gridDim.z;
    unsigned sum, cnt, mine, sp = 0u;
    for (;;) {
        sum = 0u; cnt = 0u; mine = 0u;
#pragma unroll
        for (unsigned j = 0; j < 16; ++j) { const unsigned c = xb_ld(&bar[XB_XCNT(j)]); sum += c; cnt += (c > 0u) ? 1u : 0u; mine = (j == x) ? c : mine; }
        if (sum == G) break;
        __builtin_amdgcn_s_sleep(1);
        if ((++sp & 255u) == 0u) { if (xb_ld(&bar[XB_TMO])) break; if (sp > XB_SPIN_CAP) { atomicAdd(&bar[XB_TMO], 1u); break; } }
    }
    nloc = mine > 0u ? mine : 1u; nx = cnt > 0u ? cnt : 1u;
}

__device__ __forceinline__ void xcd_barrier(const XcdBarrier& b) {
    asm volatile("s_waitcnt vmcnt(0)" ::: "memory");
    __syncthreads();
    if (threadIdx.x == 0) {
        unsigned* bar = b.bar;
        __builtin_amdgcn_s_waitcnt(0);
        unsigned nloc = b.st[0], nx = b.st[1];
        if (nloc == 0u) { xcd_barrier_complete(bar, b.x, nloc, nx); b.st[0] = nloc; b.st[1] = nx; }
        const unsigned old = xb_add(&bar[XB_XSUB(b.x)], 1u);
        const unsigned gen = old / nloc;
        if (old + 1u == (gen + 1u) * nloc) {
            __builtin_amdgcn_fence(__ATOMIC_RELEASE, "agent");
            asm volatile("s_waitcnt vmcnt(0)" ::: "memory");
            const unsigned og = xb_add(&bar[XB_TOP], 1u);
            const unsigned tg = og / nx;
            if (og + 1u == (tg + 1u) * nx) xb_add(&bar[XB_TOPGEN], 1u);
            else XB_SPIN(xb_ld(&bar[XB_TOPGEN]) == tg, bar);
            __builtin_amdgcn_fence(__ATOMIC_ACQUIRE, "agent");
            xb_add(&bar[XB_XGEN(b.x)], 1u);
            asm volatile("s_waitcnt vmcnt(0)" ::: "memory");
        } else {
            XB_SPIN(xb_ld(&bar[XB_XGEN(b.x)]) == gen, bar);
            __builtin_amdgcn_fence(__ATOMIC_ACQUIRE, "agent");
            asm volatile("s_waitcnt vmcnt(0)" ::: "memory");
        }
    }
    __syncthreads();
}
constexpr int CW_CONV = 8192;
struct Args { const float* in[20]; float* out; unsigned char* ws; int ph_lo, ph_hi; };

__global__ void __launch_bounds__(NWAVES * 64, 2) mk_fwd(Args args) {
    extern __shared__ __attribute__((aligned(16))) unsigned char lds[];
    cg::grid_group grid = cg::this_grid();
    const int tid = threadIdx.x, lane = tid & 63, wave = __builtin_amdgcn_readfirstlane(tid >> 6);
    const int G = gridDim.x, bx = blockIdx.x, vcu = (G % 8 == 0) ? (bx % 8) * (G / 8) + bx / 8 : bx;
    const int gw = vcu * NWAVES + wave, NGW = G * NWAVES;
    unsigned char* ws = args.ws;
    const float* x_prompt = args.in[0]; const float* x_sample = args.in[1]; const float* meta = args.in[2];
    bf16* WGU1 = (bf16*)(ws + WS_WGU1); bf16* WD1 = (bf16*)(ws + WS_WD1); bf16* WGU2 = (bf16*)(ws + WS_WGU2); bf16* WD2 = (bf16*)(ws + WS_WD2);
    bf16* WIN = (bf16*)(ws + WS_WIN); bf16* WUQ = (bf16*)(ws + WS_WUQ); bf16* WUKV = (bf16*)(ws + WS_WUKV); bf16* WOUT = (bf16*)(ws + WS_WOUT);
    bf16* XN = (bf16*)(ws + WS_XN); bf16* KVB = XN; bf16* HB = (bf16*)(ws + WS_H); bf16* UB = (bf16*)(ws + WS_U); bf16* QL = (bf16*)(ws + WS_QL); bf16* KVL = (bf16*)(ws + WS_KVL);
    bf16* KR = (bf16*)(ws + WS_KR); bf16* QB = (bf16*)(ws + WS_Q); bf16* MIX = (bf16*)(ws + WS_MIX);
    float* SSA = (float*)(ws + WS_SSA); float* SSM = SSA + (size_t)MALLR * 4;
    float* SSB = (float*)(ws + WS_SSB); float* ROPE = (float*)(ws + WS_ROPE);
    float* out = args.out;
    bf16* X1B = (bf16*)args.out;
    LAS unsigned char* ldsl = (LAS unsigned char*)lds;
    const int lo = args.ph_lo, hi = args.ph_hi;
    volatile LAS unsigned* MISC = (volatile LAS unsigned*)(ldsl + MISC_OFF);
    if (tid < 64) MISC[tid] = 0u;
    __syncthreads();
    XcdBarrier bar; bar.bar = (unsigned*)(ws + WS_CTL); bar.x = 0; bar.st = nullptr;
    if (N_LAUNCHES == 1) bar = xcd_barrier_post((unsigned*)(ws + WS_CTL), MISC + 8);
#ifdef ONLYMASK
#define IN(k) (((ONLYMASK >> (k)) & 1) && lo <= (k) && (k) < hi)
#else
#define IN(k) (lo <= (k) && (k) < hi)
#endif
#define SEAM(k) do { if (IN(k) && IN((k) + 1)) { if (lo < 0) grid.sync(); else xcd_barrier(bar); } } while (0)
#ifndef DUP_MASK
#define DUP_MASK 0
#endif
#define REP(k) for (int rep_ = 0; rep_ < 1 + ((DUP_MASK >> (k)) & 1); ++rep_)

    constexpr int I_G = 16 * 88, I_D = 44 * 32, I_IN = 16 * 69, I_UQ = 6 * 24, I_UKV = 4 * 32, I_O = 16 * 32;
    constexpr int NITEMS = 4 * I_G + 2 * I_D + I_IN + I_UQ + I_UKV + I_O;
    const int NOW_ITEMS = (G == 256) ? 2 * I_G : NITEMS;
    LAS float* scr = (LAS float*)(ldsl + wave * 16384);
#define CONVERT_ITEMS(FIRST, LAST, WIDX, WSTRIDE) do { \
        for (int it = (FIRST) + (WIDX); it < (LAST); it += (WSTRIDE)) { \
            int r = it; \
            if (r < 4 * I_G) { const int which = r / I_G, q = r % I_G, kb = q / 88, nb = q % 88; \
                const float* W = args.in[which == 0 ? 4 : which == 1 ? 5 : which == 2 ? 16 : 17]; \
                p0_transpose_item(W, DM, DFF, which < 2 ? WGU1 : WGU2, 64 * kb, 32 * nb, map_gu(32 * nb, which & 1), scr, lane, args.in[which < 2 ? 3 : 15]); continue; } \
            r -= 4 * I_G; \
            if (r < 2 * I_D) { const int which = r / I_D, q = r % I_D, kb = q / 32, nb = q % 32; \
                p0_transpose_item(args.in[which ? 18 : 6], DFF, DM, which ? WD2 : WD1, 64 * kb, 32 * nb, 32 * nb, scr, lane); continue; } \
            r -= 2 * I_D; \
            if (r < I_IN) { const int kb = r / 69, nb = r % 69; p0_transpose_item(args.in[8], DM, DIN, WIN, 64 * kb, 32 * nb, map_win(32 * nb), scr, lane, args.in[7]); continue; } \
            r -= I_IN; \
            if (r < I_UQ) { const int kb = r / 24, nb = r % 24; p0_transpose_item(args.in[11], 384, 768, WUQ, 64 * kb, 32 * nb, 32 * nb, scr, lane); continue; } \
            r -= I_UQ; \
            if (r < I_UKV) { const int kb = r / 32, nb = r % 32; p0_transpose_item(args.in[13], 256, 1024, WUKV, 64 * kb, 32 * nb, 32 * nb, scr, lane); continue; } \
            r -= I_UKV; \
            { const int kb = r / 32, nb = r % 32; p0_transpose_item(args.in[14], DM, DM, WOUT, 64 * kb, 32 * nb, 32 * nb, scr, lane); } \
        } \
    } while (0)
    if (IN(0)) REP(0) {
        CONVERT_ITEMS(0, NOW_ITEMS, gw, NGW);
        for (int i = gw * 64 + lane; i < 96 * DM / 8; i += NGW * 64) ((v4u*)(WIN + (size_t)DIN * DM))[i] = (v4u){0u, 0u, 0u, 0u};
        for (int i = gw * 64 + lane; i < 4112 * 16; i += NGW * 64) { const int pos = i >> 4, j = i & 15;
            const double b4 = (j & 3) == 0 ? 1.0 : (j & 3) == 1 ? 0.5623413251903491 : (j & 3) == 2 ? 0.31622776601683794 : 0.1778279410038923;
            const double p10 = (j >> 2) == 0 ? 1.0 : (j >> 2) == 1 ? 0.1 : (j >> 2) == 2 ? 0.01 : 0.001;
            const double rev = (double)pos * (b4 * p10) * 0.15915494309189535; const float fr = (float)(rev - __builtin_floor(rev));
            ROPE[2 * i] = __builtin_amdgcn_cosf(fr); ROPE[2 * i + 1] = __builtin_amdgcn_sinf(fr); }
        for (int i = gw * 64 + lane; i < 240 * DM / 8; i += NGW * 64) ((v4u*)(X1B + (size_t)(NREAL + 16) * DM))[i] = (v4u){0u, 0u, 0u, 0u};
        for (int m0 = gw; m0 < MALLR; m0 += 2 * NGW) {
            f32x4 v[2][4]; bool live[2];
#pragma unroll
            for (int k = 0; k < 2; ++k) { const int m = m0 + k * NGW; live[k] = m < MALLR;
                const float* src = m < NPROMPT ? x_prompt + (size_t)m * DM : (m < NREAL ? x_sample + (size_t)(m - NPROMPT) * DM : meta + (size_t)((m - NREAL) & 15) * DM);
                const bool have = m < NREAL + 16;
#pragma unroll
                for (int j = 0; j < 4; ++j) v[k][j] = have ? ((const f32x4*)src)[lane + 64 * j] : (f32x4){0.f, 0.f, 0.f, 0.f}; }
#pragma unroll
            for (int k = 0; k < 2; ++k) { if (!live[k]) continue; const int m = m0 + k * NGW; float s = 0.f;
#pragma unroll
                for (int j = 0; j < 4; ++j) s += (v[k][j][0] * v[k][j][0] + v[k][j][1] * v[k][j][1]) + (v[k][j][2] * v[k][j][2] + v[k][j][3] * v[k][j][3]);
                s = wave_sum(s);
                const float rs0 = __builtin_amdgcn_rsqf(s * (1.0f / 1024.0f) + 1e-6f);
                unsigned long long* o8 = (unsigned long long*)(XN + (size_t)m * DM) + lane;
#pragma unroll
                for (int j = 0; j < 4; ++j) o8[64 * j] = (unsigned long long)pk2(v[k][j][0] * rs0, v[k][j][1] * rs0) | ((unsigned long long)pk2(v[k][j][2] * rs0, v[k][j][3] * rs0) << 32);
                if (m >= NREAL && lane < 16) SSM[(size_t)(m - NREAL) * 16 + lane] = 0.f; }
        }
    }
    SEAM(0);
    if (IN(1)) REP(1) { pg8::Gemm g{XN, WGU1, MALLR, NGU, DM}; pg8::StaticOrder S; S.init(MALLR, NGU, G, bx);
        pg8::EpiGateUpT<true> E{HB, SSA};
        pg8::gemm_phase<pg8::EpiGateUpT<true>, pg8::StaticOrder, true, true>(ldsl, g, S, E);
        if (G == 256 && bx >= 150) CONVERT_ITEMS(2 * I_G, NITEMS, (bx - 150) * NWAVES + wave, 106 * NWAVES); }
    SEAM(1);
    if (IN(2)) REP(2) {
        if (vcu < 16) {
            typedef short bf16x8s __attribute__((ext_vector_type(8)));
            const int quad = lane >> 4, l15 = lane & 15, kbeg = wave * 352;
            const bf16* ap = HB + (size_t)(NREAL + l15) * DFF + kbeg + 8 * quad;
            const bf16* bp = WD1 + (size_t)(64 * vcu + l15) * DFF + kbeg + 8 * quad;
            f32x4 macc[4];
#pragma unroll
            for (int c = 0; c < 4; ++c) macc[c] = (f32x4){0.f, 0.f, 0.f, 0.f};
#pragma unroll
            for (int st = 0; st < 11; ++st) { const bf16x8s a = *(const bf16x8s*)(ap + 32 * st);
#pragma unroll
                for (int c = 0; c < 4; ++c) { const bf16x8s b = *(const bf16x8s*)(bp + (size_t)c * 16 * DFF + 32 * st); macc[c] = __builtin_amdgcn_mfma_f32_16x16x32_bf16(a, b, macc[c], 0, 0, 0); } }
            LAS f32x4* red = (LAS f32x4*)ldsl;
#pragma unroll
            for (int c = 0; c < 4; ++c) red[(wave * 4 + c) * 64 + lane] = macc[c];
            __syncthreads();
            if (wave == 0) {
                float ssr[4] = {0.f, 0.f, 0.f, 0.f};
#pragma unroll
                for (int c = 0; c < 4; ++c) { f32x4 t = red[c * 64 + lane];
#pragma unroll
                    for (int w = 1; w < 8; ++w) t += red[(w * 4 + c) * 64 + lane];
                    const int col = 64 * vcu + 16 * c + l15;
#pragma unroll
                    for (int i = 0; i < 4; ++i) { const int row = 4 * quad + i; const float xv = meta[(size_t)row * DM + col] + 0.5f * t[i]; ssr[i] += xv * xv;
                        X1B[(size_t)(NREAL + row) * DM + col] = (bf16)f2bf(xv); } }
#pragma unroll
                for (int i = 0; i < 4; ++i) { float sv = ssr[i]; sv += __shfl_xor(sv, 1); sv += __shfl_xor(sv, 2); sv += __shfl_xor(sv, 4); sv += __shfl_xor(sv, 8);
                    if (l15 == 0) SSM[(size_t)(4 * quad + i) * 16 + vcu] = sv; }
            }
            __syncthreads();
        }
        pg8::Gemm g{HB, WD1, NREAL, DM, DFF}; pg8::StaticOrder S; S.init(NREAL, DM, G, bx);
        pg8::EpiResidB<0> E{x_prompt, x_sample, nullptr, X1B, SSA, 0.5f};
        pg8::gemm_phase<pg8::EpiResidB<0>, pg8::StaticOrder, true, true>(ldsl, g, S, E); }
    SEAM(2);
    if (IN(3)) REP(3) { pg8::Gemm g{X1B, WIN, MALLR, NINP, DM}; pg8::StaticOrder S; S.init(MALLR, NINP, G, bx);
        pg8::EpiWin E{SSA, MIX, UB, QL, KVL, KR, SSB, args.in[10], args.in[12], ROPE};
        pg8::gemm_phase<pg8::EpiWin, pg8::StaticOrder, true, true>(ldsl, g, S, E); }
    SEAM(3);
    if (IN(4)) {
#ifndef P4_SKIP_Q
        { int kq = 384; asm volatile("" : "+s"(kq)); pg8::Gemm g{QL, WUQ, NREAL, 768, kq}; pg8::StaticOrder S; S.init(NREAL, 768, G, bx);
          pg8::EpiQup E{SSB, QB, ROPE};
          pg8::gemm_phase<pg8::EpiQup, pg8::StaticOrder, true, true>(ldsl, g, S, E); }
#endif
#ifndef P4_SKIP_KV
        if (gw < 64) {
            typedef short bf16x8s __attribute__((ext_vector_type(8)));
            const int quad = lane >> 4, l15 = lane & 15;
            const bf16* ap = KVL + (size_t)(NREAL + l15) * 256 + 8 * quad; const bf16* bp = WUKV + (size_t)(16 * gw + l15) * 256 + 8 * quad;
            f32x4 kacc = (f32x4){0.f, 0.f, 0.f, 0.f};
#pragma unroll
            for (int st = 0; st < 8; ++st) kacc = __builtin_amdgcn_mfma_f32_16x16x32_bf16(*(const bf16x8s*)(ap + 32 * st), *(const bf16x8s*)(bp + 32 * st), kacc, 0, 0, 0);
#pragma unroll
            for (int i = 0; i < 4; ++i) { const size_t row = (size_t)NREAL + 4 * quad + i; const f32x4* sp = (const f32x4*)(SSB + row * 32 + 12); const f32x4 v0 = sp[0], v1 = sp[1];
                const float sv = ((v0[0] + v0[1]) + (v0[2] + v0[3])) + ((v1[0] + v1[1]) + (v1[2] + v1[3]));
                KVB[row * DM + 16 * gw + l15] = (bf16)f2bf(kacc[i] * __builtin_amdgcn_rsqf(sv * (1.0f / 256.0f) + 1e-6f)); }
        }
        { int kk = 256; asm volatile("" : "+s"(kk)); pg8::Gemm g{KVL, WUKV, NREAL, 1024, kk}; pg8::StaticOrder S; S.init(NREAL, 1024, G, bx);
          pg8::EpiKVup E{SSB, KVB};
          pg8::gemm_phase<pg8::EpiKVup, pg8::StaticOrder, true, true>(ldsl, g, S, E); }
#endif
#ifndef P4_SKIP_CONV
        const float* cw = args.in[9];
        f32x4 w0a = ((const f32x4*)cw)[2 * lane], w0b = ((const f32x4*)cw)[2 * lane + 1], w1a = ((const f32x4*)(cw + 512))[2 * lane], w1b = ((const f32x4*)(cw + 512))[2 * lane + 1],
              w2a = ((const f32x4*)(cw + 1024))[2 * lane], w2b = ((const f32x4*)(cw + 1024))[2 * lane + 1];
        int cbeg, cend, cstep;
        if (G == 256) { cbeg = (bx < 64 ? bx * 120 : 7680 + (bx - 64) * 216); cend = cbeg + (bx < 64 ? 120 : 216); cbeg += wave; cstep = NWAVES; }
        else { cbeg = gw; cend = NREAL; cstep = NGW; }
        {
          for (int m = cbeg; m < cend; m += cstep) {
            const int t = m < NPROMPT ? (m & 4095) : ((m - NPROMPT) & 2047), L = m < NPROMPT ? 4096 : 2048;
            const v4u uc = *((const v4u*)(UB + (size_t)m * 512) + lane);
            const v4u up = *((const v4u*)(UB + (size_t)(t == 0 ? NREAL + 15 : m - 1) * 512) + lane);
            v4u un = (v4u){0u, 0u, 0u, 0u}; if (t != L - 1) un = *((const v4u*)(UB + (size_t)(m + 1) * 512) + lane);
            v4u* bp = (v4u*)(MIX + (size_t)m * DM) + lane; const v4u b = *bp; v4u y;
#define CONV2(k, WA0, WA1, WB0, WB1, WC0, WC1) y[k] = pk2(bflo(b[k]) * (WA0 * bflo(up[k]) + WB0 * bflo(uc[k]) + WC0 * bflo(un[k])), bfhi(b[k]) * (WA1 * bfhi(up[k]) + WB1 * bfhi(uc[k]) + WC1 * bfhi(un[k])))
            CONV2(0, w0a[0], w0a[1], w1a[0], w1a[1], w2a[0], w2a[1]); CONV2(1, w0a[2], w0a[3], w1a[2], w1a[3], w2a[2], w2a[3]);
            CONV2(2, w0b[0], w0b[1], w1b[0], w1b[1], w2b[0], w2b[1]); CONV2(3, w0b[2], w0b[3], w1b[2], w1b[3], w2b[2], w2b[3]);
#undef CONV2
            *bp = y;
          }
        }
#endif
    }
    SEAM(4);
    if (IN(5)) REP(5) att::attn_phase(QB, KVB, KR, MIX, vcu, G, (char*)lds);
    SEAM(5);
    if (IN(6)) { pg8::Gemm g{MIX, WOUT, NREAL, DM, DM}; pg8::StaticOrder S; S.init(NREAL, DM, G, bx);
        pg8::EpiResidB<1> E{nullptr, nullptr, X1B, XN, SSA, 1.0f};
        pg8::gemm_phase<pg8::EpiResidB<1>, pg8::StaticOrder, true, true>(ldsl, g, S, E); }
    SEAM(6);
    if (IN(7)) { pg8::Gemm g{XN, WGU2, NREAL, NGU, DM}; pg8::StaticOrder S; S.init(NREAL, NGU, G, bx);
        pg8::EpiGateUp E{HB, SSA};
        pg8::gemm_phase<pg8::EpiGateUp, pg8::StaticOrder, true, true>(ldsl, g, S, E); }
    SEAM(7);
    if (IN(8)) { pg8::Gemm g{HB, WD2, NREAL, DM, DFF}; pg8::StaticOrder S; S.init(NREAL, DM, G, bx);
        pg8::EpiResidB<1> E{nullptr, nullptr, XN, XN, SSA, 0.5f};
        pg8::gemm_phase<pg8::EpiResidB<1>, pg8::StaticOrder, true, true>(ldsl, g, S, E); }
    SEAM(8);
    if (IN(9)) {
        const float* gf = args.in[19];
        f32x4 gq[4];
#pragma unroll
        for (int j = 0; j < 4; ++j) gq[j] = ((const f32x4*)gf)[(j >> 1) * 128 + 2 * lane + (j & 1)];
        for (int m0 = gw; m0 < NREAL; m0 += 4 * NGW) {
            v4u xa[4], xb[4]; float sv[4];
#pragma unroll
            for (int k = 0; k < 4; ++k) { const int m = m0 + k * NGW < NREAL ? m0 + k * NGW : m0;
                sv[k] = lane < 4 ? SSA[(size_t)m * 4 + lane] : 0.f;
                const v4u* xr = (const v4u*)(XN + (size_t)m * DM); xa[k] = xr[lane]; xb[k] = xr[64 + lane]; }
#pragma unroll
            for (int k = 0; k < 4; ++k) { const int m = m0 + k * NGW; if (m >= NREAL) continue;
                const float rs = __builtin_amdgcn_rsqf(wave_sum(sv[k]) * (1.0f / 1024.0f) + 1e-6f);
                f32x4* p = (f32x4*)(out + (size_t)m * DM);
                p[2 * lane] = (f32x4){bflo(xa[k][0]), bfhi(xa[k][0]), bflo(xa[k][1]), bfhi(xa[k][1])} * rs * gq[0];
                p[2 * lane + 1] = (f32x4){bflo(xa[k][2]), bfhi(xa[k][2]), bflo(xa[k][3]), bfhi(xa[k][3])} * rs * gq[1];
                p[128 + 2 * lane] = (f32x4){bflo(xb[k][0]), bfhi(xb[k][0]), bflo(xb[k][1]), bfhi(xb[k][1])} * rs * gq[2];
                p[128 + 2 * lane + 1] = (f32x4){bflo(xb[k][2]), bfhi(xb[k][2]), bflo(xb[k][3]), bfhi(xb[k][3])} * rs * gq[3]; }
        }
    }
#undef IN
#undef SEAM
}

extern "C" void kernel_launch(void* const* d_in, const int* in_sizes, int n_in, void* d_out, int out_size, void* d_ws, size_t ws_size, hipStream_t stream) {
    static int grid = 0;
    if (grid == 0) {
        if (n_in != 20 || out_size != NREAL * DM || ws_size < WS_END) { fprintf(stderr, "kernel_launch: unexpected shapes: n_in %d out %d ws %zu (need >= %zu)\n", n_in, out_size, ws_size, (size_t)WS_END); grid = -1; return; }
        int dev = 0, cus = 0, per_cu = 0;
        if (hipGetDevice(&dev) != hipSuccess || hipDeviceGetAttribute(&cus, hipDeviceAttributeMultiprocessorCount, dev) != hipSuccess) { fprintf(stderr, "kernel_launch: device query failed\n"); grid = -1; return; }
        if (hipFuncSetAttribute((const void*)mk_fwd, hipFuncAttributeMaxDynamicSharedMemorySize, LDS_BYTES) != hipSuccess) { fprintf(stderr, "kernel_launch: hipFuncSetAttribute failed\n"); grid = -1; return; }
        if (hipOccupancyMaxActiveBlocksPerMultiprocessor(&per_cu, (const void*)mk_fwd, NWAVES * 64, LDS_BYTES) != hipSuccess || per_cu < 1) { fprintf(stderr, "kernel_launch: occupancy query says %d\n", per_cu); per_cu = 1; }
        (void)hipGetLastError();
        grid = cus * 1;
        fprintf(stderr, "kernel_launch: grid %d (cus %d, per_cu %d), ws %zu need %zu\n", grid, cus, per_cu, ws_size, (size_t)WS_END);
    }
    if (grid < 0) return;
    Args a{};
    for (int i = 0; i < 20; ++i) a.in[i] = (const float*)d_in[i];
    a.out = (float*)d_out; a.ws = (unsigned char*)d_ws;
    if (hipMemsetAsync((char*)d_ws + WS_CTL, 0, CTL_BYTES, stream) != hipSuccess) { fprintf(stderr, "kernel_launch: memset failed\n"); return; }
    if (N_LAUNCHES == 1) {
        a.ph_lo = 0; a.ph_hi = N_PHASES;
        void* kargs[] = {&a};
        const hipError_t e = hipLaunchCooperativeKernel((const void*)mk_fwd, dim3(grid), dim3(NWAVES * 64), kargs, LDS_BYTES, stream);
        if (e != hipSuccess) fprintf(stderr, "kernel_launch: cooperative launch failed: %s (grid %d)\n", hipGetErrorString(e), grid);
    } else {
#ifndef PROBE_DUP
#define PROBE_DUP -1
#endif
        for (int p = 0; p < N_PHASES; ++p) for (int rep = 0; rep < (p == PROBE_DUP ? 2 : 1); ++rep) { a.ph_lo = p; a.ph_hi = p + 1;
            hipLaunchKernelGGL(mk_fwd, dim3(grid), dim3(NWAVES * 64), LDS_BYTES, stream, a);
            const hipError_t le = hipPeekAtLastError();
            if (le != hipSuccess) { fprintf(stderr, "kernel_launch: launch %d failed: %s\n", p, hipGetErrorName(le)); break; } }
    }
}
```
